# Optimizing an MI355X kernel written in HIP

```python
import math
import jax, jax.numpy as jnp
from jax import lax
import numpy as np

D_MODEL = 1024
BATCH = 4
SEQ = 4096
DEPTH = 1
DEC_BATCH = 32
DEC_SEQ = 1
PAST_LEN = 8192
PAGE_SIZE = 128

D_MIX = D_MODEL
D_RET = D_MIX // 2
D_DIFF = D_MIX - D_RET
H_RET = 4
DK_RET = D_RET // H_RET
DV_RET = D_RET // H_RET
H_DIFF = 4
DV_DIFF = D_DIFF // H_DIFF
DH_DIFF = DV_DIFF // 2
ROT_DIFF = DH_DIFF // 4
ROPE_THETA = 500000.0
RET_ROPE_THETA = 10000.0
RET_CHUNK = 128
Q_BLOCK = 128
EPS = 1e-6
NEG_INF = -1e30

kernel_name = "hymba_retention_diffattn_step"


def rms_norm(x, g):
    xf = x.astype(jnp.float32)
    y = xf * lax.rsqrt(jnp.mean(xf * xf, axis=-1, keepdims=True) + EPS)
    return (y * g.astype(jnp.float32)).astype(x.dtype)


def rope(x, pos, theta, n_rot):
    half = n_rot // 2
    freqs = theta ** (-jnp.arange(0, n_rot, 2, dtype=jnp.float32) / n_rot)
    ang = pos.astype(jnp.float32)[:, None] * freqs[None, :]
    ang = ang.reshape((1, pos.shape[0]) + (1,) * (x.ndim - 3) + (half,))
    cos, sin = jnp.cos(ang), jnp.sin(ang)
    xf = x.astype(jnp.float32)
    x1, x2, rest = xf[..., :half], xf[..., half:n_rot], xf[..., n_rot:]
    out = jnp.concatenate([x1 * cos - x2 * sin, x2 * cos + x1 * sin, rest], axis=-1)
    return out.astype(x.dtype)


def project(h, w_in, pos, g_q, g_k):
    B, L, _ = h.shape
    z = jnp.einsum('bld,de->ble', h, w_in)
    sizes = (D_RET,) * 4 + (D_DIFF,) * 4
    offs = np.cumsum(sizes)[:-1].tolist()
    rq, rk, rv, rg, dq, dk, dv, dg = jnp.split(z, offs, axis=-1)
    rq = rope(rq.reshape(B, L, H_RET, DK_RET), pos, RET_ROPE_THETA, DK_RET)
    rk = rope(rk.reshape(B, L, H_RET, DK_RET), pos, RET_ROPE_THETA, DK_RET) * (DK_RET ** -0.5)
    rv = rv.reshape(B, L, H_RET, DV_RET)
    dq = rope(rms_norm(dq.reshape(B, L, H_DIFF, 2, DH_DIFF), g_q), pos, ROPE_THETA, ROT_DIFF)
    dk = rope(rms_norm(dk.reshape(B, L, H_DIFF, 2, DH_DIFF), g_k), pos, ROPE_THETA, ROT_DIFF)
    dv = dv.reshape(B, L, H_DIFF, DV_DIFF)
    return rq, rk, rv, rg, dq, dk, dv, dg


def retention_chunk(S, q, k, v):
    L = q.shape[1]
    log_g = jnp.log(1.0 - 2.0 ** (-5.0 - jnp.arange(H_RET, dtype=jnp.float32)))
    idx = jnp.arange(L, dtype=jnp.float32)
    rel = idx[:, None] - idx[None, :]
    dmask = jnp.where(rel[None] >= 0, jnp.exp(log_g[:, None, None] * jnp.maximum(rel, 0.0)[None]), 0.0)
    inner = jnp.einsum('bihd,bjhd->bhij', q, k) * dmask[None]
    o_intra = jnp.einsum('bhij,bjhe->bihe', inner, v)
    q_dec = jnp.exp(log_g[None, :] * (idx[:, None] + 1.0))
    o_cross = jnp.einsum('bihd,bhde->bihe', q * q_dec[None, :, :, None], S)
    k_dec = jnp.exp(log_g[None, :] * (L - 1.0 - idx)[:, None])
    S_new = jnp.exp(log_g * L)[None, :, None, None] * S + jnp.einsum(
        'bjhd,bjhe->bhde', k * k_dec[None, :, :, None], v)
    return o_intra + o_cross, S_new


def retention_prompt(q, k, v):
    B, L = q.shape[0], q.shape[1]
    nc = L // RET_CHUNK
    def to_chunks(t):
        return jnp.moveaxis(t.astype(jnp.float32).reshape((B, nc, RET_CHUNK) + t.shape[2:]), 1, 0)
    S0 = jnp.zeros((B, H_RET, DK_RET, DV_RET), jnp.float32)
    def step(S, qkv):
        o, S = retention_chunk(S, *qkv)
        return S, o
    S_fin, o = lax.scan(step, S0, (to_chunks(q), to_chunks(k), to_chunks(v)))
    o = jnp.moveaxis(o, 0, 1).reshape(B, L, H_RET, DV_RET)
    return o, S_fin


def diff_attend(q, q_pos, k, k_pos, v, lam):
    s = jnp.einsum('bqhcd,bkhcd->bhcqk', q, k).astype(jnp.float32) * (DH_DIFF ** -0.5)
    mask = k_pos[None, :] <= q_pos[:, None]
    s = jnp.where(mask[None, None, None], s, NEG_INF)
    p = jax.nn.softmax(s, axis=-1)
    a = p[:, :, 0] - lam * p[:, :, 1]
    return jnp.einsum('bhqk,bkhe->bqhe', a, v.astype(jnp.float32))


def diff_prompt(q, k, v, lam):
    B, L = q.shape[0], q.shape[1]
    nb = L // Q_BLOCK
    pos = jnp.arange(L)
    qb = jnp.moveaxis(q.reshape((B, nb, Q_BLOCK) + q.shape[2:]), 1, 0)
    pb = pos.reshape(nb, Q_BLOCK)
    o = lax.map(lambda a: diff_attend(a[0], a[1], k, pos, v, lam), (qb, pb))
    return jnp.moveaxis(o, 0, 1).reshape(B, L, H_DIFF, DV_DIFF)


def merge(x, o_ret, o_diff, rg, dg, g_ret_out, g_diff_out, lam_init, w_out):
    B, L, _ = x.shape
    o_ret = rms_norm(o_ret, g_ret_out).astype(x.dtype).reshape(B, L, D_RET)
    o_diff = (rms_norm(o_diff, g_diff_out) * (1.0 - lam_init)).astype(x.dtype).reshape(B, L, D_DIFF)
    u = jnp.concatenate([o_ret * jax.nn.silu(rg), o_diff * jax.nn.silu(dg)], axis=-1)
    return x + jnp.einsum('bld,de->ble', u, w_out)


def setup_inputs(seed: int = 0) -> dict:
    key = jax.random.key(seed)
    ks = jax.random.split(key, 20)
    n_pages = PAST_LEN // PAGE_SIZE
    n_used = DEC_BATCH * n_pages
    n_phys = n_used + n_used // 4
    page_table = jax.random.permutation(ks[0], n_phys)[:n_used].reshape(DEC_BATCH, n_pages).astype(jnp.int32)
    f32 = jnp.float32
    return {
        "x_prompt": jax.random.normal(ks[1], (BATCH, SEQ, D_MODEL), f32),
        "x_sample": jax.random.normal(ks[2], (DEC_BATCH, DEC_SEQ, D_MODEL), f32),
        "cache_k": jax.random.normal(ks[3], (DEPTH, n_phys, PAGE_SIZE, H_DIFF, 2, DH_DIFF), f32),
        "cache_v": jax.random.normal(ks[4], (DEPTH, n_phys, PAGE_SIZE, H_DIFF, DV_DIFF), f32),
        "state_ret": 0.5 * jax.random.normal(ks[5], (DEPTH, DEC_BATCH, H_RET, DK_RET, DV_RET), f32),
        "page_table": page_table,
        "norm_g": 1.0 + 0.01 * jax.random.normal(ks[6], (DEPTH, D_MODEL), f32),
        "w_in": jax.random.normal(ks[7], (DEPTH, D_MODEL, 4 * D_MIX), f32) * D_MODEL ** -0.5,
        "w_out": jax.random.normal(ks[8], (DEPTH, D_MIX, D_MODEL), f32) * D_MIX ** -0.5,
        "q_norm_g": 1.0 + 0.01 * jax.random.normal(ks[9], (DEPTH, DH_DIFF), f32),
        "k_norm_g": 1.0 + 0.01 * jax.random.normal(ks[10], (DEPTH, DH_DIFF), f32),
        "ret_out_g": 1.0 + 0.01 * jax.random.normal(ks[11], (DEPTH, DV_RET), f32),
        "diff_out_g": 1.0 + 0.01 * jax.random.normal(ks[12], (DEPTH, DV_DIFF), f32),
        "lambda_q1": 0.1 * jax.random.normal(ks[13], (DEPTH, DH_DIFF), f32),
        "lambda_k1": 0.1 * jax.random.normal(ks[14], (DEPTH, DH_DIFF), f32),
        "lambda_q2": 0.1 * jax.random.normal(ks[15], (DEPTH, DH_DIFF), f32),
        "lambda_k2": 0.1 * jax.random.normal(ks[16], (DEPTH, DH_DIFF), f32),
    }


def reference(x_prompt, x_sample, cache_k, cache_v, state_ret, page_table, norm_g, w_in, w_out,
              q_norm_g, k_norm_g, ret_out_g, diff_out_g, lambda_q1, lambda_k1, lambda_q2, lambda_k2):
    n_pages = PAST_LEN // PAGE_SIZE
    past = n_pages * PAGE_SIZE
    pos_p = jnp.arange(SEQ)
    pos_s = past + jnp.arange(DEC_SEQ)
    k_pos_s = jnp.arange(past + DEC_SEQ)
    yp, ys = x_prompt, x_sample
    nkp, nvp, nsp, nks, nvs, nss = [], [], [], [], [], []
    for l in range(DEPTH):
        lam_init = 0.8 - 0.6 * math.exp(-0.3 * l)
        lam = (jnp.exp(jnp.sum(lambda_q1[l].astype(jnp.float32) * lambda_k1[l].astype(jnp.float32)))
               - jnp.exp(jnp.sum(lambda_q2[l].astype(jnp.float32) * lambda_k2[l].astype(jnp.float32)))
               + lam_init)
        hp = rms_norm(yp, norm_g[l])
        rq, rk, rv, rg, dq, dk, dv, dg = project(hp, w_in[l], pos_p, q_norm_g[l], k_norm_g[l])
        o_ret, S_p = retention_prompt(rq, rk, rv)
        o_diff = diff_prompt(dq, dk, dv, lam)
        yp = merge(yp, o_ret, o_diff, rg, dg, ret_out_g[l], diff_out_g[l], lam_init, w_out[l])
        nkp.append(dk.astype(cache_k.dtype))
        nvp.append(dv.astype(cache_v.dtype))
        nsp.append(S_p.astype(state_ret.dtype))
        hs = rms_norm(ys, norm_g[l])
        rq, rk, rv, rg, dq, dk, dv, dg = project(hs, w_in[l], pos_s, q_norm_g[l], k_norm_g[l])
        o_ret, S_s = retention_chunk(state_ret[l].astype(jnp.float32), rq.astype(jnp.float32),
                                     rk.astype(jnp.float32), rv.astype(jnp.float32))
        past_k = cache_k[l][page_table].reshape(DEC_BATCH, past, H_DIFF, 2, DH_DIFF)
        past_v = cache_v[l][page_table].reshape(DEC_BATCH, past, H_DIFF, DV_DIFF)
        k_all = jnp.concatenate([past_k.astype(dk.dtype), dk], axis=1)
        v_all = jnp.concatenate([past_v.astype(dv.dtype), dv], axis=1)
        o_diff = diff_attend(dq, pos_s, k_all, k_pos_s, v_all, lam)
        ys = merge(ys, o_ret, o_diff, rg, dg, ret_out_g[l], diff_out_g[l], lam_init, w_out[l])
        nks.append(dk.astype(cache_k.dtype))
        nvs.append(dv.astype(cache_v.dtype))
        nss.append(S_s.astype(state_ret.dtype))
    return (yp, ys, jnp.stack(nkp), jnp.stack(nvp), jnp.stack(nsp),
            jnp.stack(nks), jnp.stack(nvs), jnp.stack(nss))
```

```cpp
#define MK_N_LAUNCHES 1
#define MK_MASK 63
#include <hip/hip_runtime.h>
#include <cstdio>
#include <cstdint>

typedef unsigned short u16;
constexpr int DM = 1024, NB = 4, SEQ = 4096, M = NB * SEQ, DB = 32, PAST = 8192, PAGE = 128, NPAGES = 64;
constexpr int NZ = 4096;
constexpr float EPS = 1e-6f;
constexpr float LOG2E = 1.4426950408889634f;
constexpr float C2 = 0.125f * LOG2E;
constexpr float LAM_INIT = 0.2f;
constexpr size_t O_YP = 0, O_YS = O_YP + (size_t)M * DM, O_KP = O_YS + (size_t)DB * DM, O_VP = O_KP + (size_t)M * 512, O_RP = O_VP + (size_t)M * 512,
                 O_KS = O_RP + (size_t)NB * 4 * 128 * 128, O_VS = O_KS + (size_t)DB * 512, O_RS = O_VS + (size_t)DB * 512, O_END = O_RS + (size_t)DB * 4 * 128 * 128;
constexpr size_t MiB = 1u << 20;
constexpr size_t WS_CTL = 0, WS_WT1 = 2 * MiB, WS_WT2 = 10 * MiB, WS_XN = 16 * MiB, WS_RQ = 48 * MiB, WS_RK = 64 * MiB, WS_KTD = 80 * MiB, WS_VT = 96 * MiB,
                 WS_GATE = 112 * MiB, WS_DQ = 144 * MiB, WS_DK = 160 * MiB, WS_DV = 176 * MiB, WS_AO = 192 * MiB, WS_RA = 224 * MiB, WS_ST = 256 * MiB, WS_U = 272 * MiB,
                 WS_DEC = 304 * MiB, WS_Z = 320 * MiB, WS_END = WS_Z + (size_t)M * NZ * 4;
constexpr size_t D_ZS = 0, D_QS = D_ZS + 32 * 4096, D_RQS = D_QS + 32 * 512, D_RKS = D_RQS + 32 * 512, D_RVS = D_RKS + 32 * 512, D_GS = D_RVS + 32 * 512, D_US = D_GS + 32 * 1024,
                 D_PART = D_US + 32 * 1024;
constexpr size_t D_ZS4 = (size_t)1 << 20;
constexpr int NSPLIT = 8, PSTR = 130;

__device__ __forceinline__ float bf2f(u16 v) { return __uint_as_float((unsigned)v << 16); }
__device__ __forceinline__ u16 f2bf(float f) { unsigned u = __float_as_uint(f); return (u16)((u + 0x7fffu + ((u >> 16) & 1u)) >> 16); }
__device__ __forceinline__ float silu(float x) { return x / (1.f + __expf(-x)); }
__device__ __forceinline__ float wave_sum(float v) {
#pragma unroll
    for (int o = 1; o < 64; o <<= 1) v += __shfl_xor(v, o);
    return v;
}
__device__ __forceinline__ float wave_max(float v) {
#pragma unroll
    for (int o = 1; o < 64; o <<= 1) v = fmaxf(v, __shfl_xor(v, o));
    return v;
}
__device__ __forceinline__ float log2_gamma(int h) { return __log2f(1.0f - exp2f(-5.0f - (float)h)); }
__device__ __forceinline__ size_t tile_idx(int b, int h, int c) { return ((size_t)(b * 4 + h) * 32 + c); }
__device__ __forceinline__ void sincos_rev(float ang, float& s, float& c) {
    float x = ang * 0.15915494309189535f; x = x - floorf(x);
    s = __builtin_amdgcn_sinf(x); c = __builtin_amdgcn_cosf(x);
}

#define GAS __attribute__((address_space(1)))
#define LAS __attribute__((address_space(3)))
namespace pg8 {
#define PG8_LAS __attribute__((address_space(3)))
typedef unsigned short bf16_t;
typedef short bf16x8 __attribute__((ext_vector_type(8)));
typedef float f32x4 __attribute__((ext_vector_type(4)));
typedef unsigned u32x4 __attribute__((ext_vector_type(4)));
constexpr int BM = 256, BK = 64, HALF = 128, HTB = HALF * BK * 2  , STAGE_BYTES = 8 * HTB, NXCD = 8, WGM = 8;

__host__ __device__ __forceinline__ int lds_byte(int r, int c) { const int st = (r >> 4) * 2 + (c >> 5), rr = r & 15, cc = c & 31, ob = rr * 64 + cc * 2; return st * 1024 + (ob ^ (((ob >> 9) & 1) << 5)); }
__host__ __device__ __forceinline__ void stage_rc(int b, int& R, int& C) { const int st = b / 1024, sb = b % 1024, swz = sb ^ (((sb >> 9) & 1) << 5); R = (st >> 1) * 16 + swz / 64; C = (st & 1) * 32 + (swz % 64) / 2; }
__host__ __device__ __forceinline__ int perm32(int rho) { const int n = rho >> 4, i = rho & 15; return 8 * (i >> 2) + 4 * n + (i & 3); }

struct Unit { int pm, pn; };
struct Gemm { const bf16_t* A; const bf16_t* Bt; int M, N, K; };

struct StaticOrder {
    int nM, nN, nwg, G, c;
    __host__ __device__ void init(int M, int N, int G_, int c_) { nM = M / BM; nN = N / BM; nwg = nM * nN; G = G_; c = c_; }
    __host__ __device__ bool next(int i, Unit& u) const {
        const long L = (long)i * G + c; if (L >= nwg) return false;
        int wgid = (int)L; { const int q = nwg / NXCD, r = nwg % NXCD, xcd = wgid % NXCD, off = wgid / NXCD; wgid = (xcd < r ? xcd * (q + 1) : r * (q + 1) + (xcd - r) * q) + off; }
        const int nig = WGM * nN, gid = wgid / nig, fm = gid * WGM, gsz = (nM - fm) < WGM ? (nM - fm) : WGM;
        u.pm = fm + ((wgid % nig) % gsz); u.pn = (wgid % nig) / gsz; return true;
    }
    __device__ __forceinline__ void a_ready(const Unit&) const {}
    __device__ __forceinline__ void done(const Unit&) const {}
};

__device__ __forceinline__ unsigned cvt_pk_bf16(float lo, float hi) { unsigned r; asm volatile("v_cvt_pk_bf16_f32 %0, %1, %2" : "=v"(r) : "v"(lo), "v"(hi)); return r; }
__device__ __forceinline__ unsigned pk_bf16(float lo, float hi) { return cvt_pk_bf16(lo, hi); }
__device__ __forceinline__ float silu_fast(float x) { return x * __builtin_amdgcn_rcpf(1.f + __builtin_amdgcn_exp2f(-1.4426950408889634f * x)); }
struct EpiProj {
    static constexpr bool PERM = true, AFTER_DRAIN = false, APERM = true;
    u16 *RQ, *RK, *KTD, *VT, *GATE, *DQ, *DK, *DV; float *outK, *outV; const float *gq, *gk;
    __device__ __forceinline__ void operator()(const f32x4 (&acc)[2][2][4][2], const Unit& u, int wr, int wc, int fr, int fq) const {
        const int sec = u.pn >> 1, half = u.pn & 1;
        const int rbase = u.pm * BM + wr * 64 + 4 * fr, b = (u.pm * BM) / SEQ, pbase = (u.pm * BM) % SEQ + wr * 64 + 4 * fr;
        if (sec <= 1) {
            const int head = 2 * half + (wc >> 1), i0 = 32 * (wc & 1) + 8 * fq;
            float frq[8];
#pragma unroll
            for (int j = 0; j < 8; ++j) frq[j] = exp2f(-(float)(i0 + j) * (13.287712379549449f / 64.f));
            const float lg = log2_gamma(head); u16* dst = sec == 0 ? RQ : RK; const float sc = sec == 0 ? 1.f : 0.08838834764831845f;
#pragma unroll
            for (int ai = 0; ai < 2; ++ai) {
                unsigned t1[8][2], t2[8][2]; float e1[8], e2[8];
#pragma unroll
                for (int m = 0; m < 4; ++m) { const int pos = pbase + ai * 128 + m; const size_t r = (size_t)(rbase + ai * 128 + m);
                    float o1[8], o2[8];
#pragma unroll
                    for (int j = 0; j < 8; ++j) { float s, c; sincos_rev((float)pos * frq[j], s, c); const float x1 = acc[ai][0][m][j >> 2][j & 3], x2 = acc[ai][1][m][j >> 2][j & 3];
                        o1[j] = (x1 * c - x2 * s) * sc; o2[j] = (x2 * c + x1 * s) * sc; }
                    u32x4 w1, w2; w1.x = pk_bf16(o1[0], o1[1]); w1.y = pk_bf16(o1[2], o1[3]); w1.z = pk_bf16(o1[4], o1[5]); w1.w = pk_bf16(o1[6], o1[7]);
                    w2.x = pk_bf16(o2[0], o2[1]); w2.y = pk_bf16(o2[2], o2[3]); w2.z = pk_bf16(o2[4], o2[5]); w2.w = pk_bf16(o2[6], o2[7]);
                    *(u32x4*)(dst + r * 512 + head * 128 + i0) = w1; *(u32x4*)(dst + r * 512 + head * 128 + 64 + i0) = w2;
                    if (sec == 1) { const float dec = __builtin_amdgcn_exp2f((float)(127 - (pos & 127)) * lg);
#pragma unroll
                        for (int j = 0; j < 8; ++j) { if (m & 1) { t1[j][m >> 1] = pk_bf16(e1[j], o1[j] * dec); t2[j][m >> 1] = pk_bf16(e2[j], o2[j] * dec); } else { e1[j] = o1[j] * dec; e2[j] = o2[j] * dec; } } } }
                if (sec == 1) { const int pos0 = pbase + ai * 128; u16* kt = KTD + tile_idx(b, head, pos0 >> 7) * 16384 + (pos0 & 127);
#pragma unroll
                    for (int j = 0; j < 8; ++j) { *(uint2*)(kt + (i0 + j) * 128) = make_uint2(t1[j][0], t1[j][1]); *(uint2*)(kt + (64 + i0 + j) * 128) = make_uint2(t2[j][0], t2[j][1]); } } }
        } else if (sec == 2) {
#pragma unroll
            for (int ai = 0; ai < 2; ++ai) { const int pos0 = pbase + ai * 128;
#pragma unroll
                for (int bj = 0; bj < 2; ++bj) { u16* vt = VT + tile_idx(b, 2 * half + bj, pos0 >> 7) * 16384 + (pos0 & 127);
#pragma unroll
                    for (int j = 0; j < 8; ++j) *(uint2*)(vt + (32 * wc + 8 * fq + j) * 128) =
                        make_uint2(pk_bf16(acc[ai][bj][0][j >> 2][j & 3], acc[ai][bj][1][j >> 2][j & 3]), pk_bf16(acc[ai][bj][2][j >> 2][j & 3], acc[ai][bj][3][j >> 2][j & 3])); } }
        } else if (sec == 3 || sec == 7) {
            const int cb = (sec == 3 ? 0 : 512) + 256 * half + 32 * wc + 8 * fq;
#pragma unroll
            for (int ai = 0; ai < 2; ++ai)
#pragma unroll
                for (int m = 0; m < 4; ++m) { const size_t r = (size_t)(rbase + ai * 128 + m);
#pragma unroll
                    for (int bj = 0; bj < 2; ++bj) { const f32x4 v0 = acc[ai][bj][m][0], v1 = acc[ai][bj][m][1]; u32x4 w;
                        w.x = pk_bf16(silu_fast(v0[0]), silu_fast(v0[1])); w.y = pk_bf16(silu_fast(v0[2]), silu_fast(v0[3])); w.z = pk_bf16(silu_fast(v1[0]), silu_fast(v1[1])); w.w = pk_bf16(silu_fast(v1[2]), silu_fast(v1[3]));
                        *(u32x4*)(GATE + r * 1024 + cb + 128 * bj) = w; } }
        } else if (sec == 4 || sec == 5) {
            const int gi = 4 * half + wc; const float* g = sec == 4 ? gq : gk;
            float gv[2][8], frq[8];
#pragma unroll
            for (int j = 0; j < 8; ++j) { gv[0][j] = g[16 * fq + j]; gv[1][j] = g[16 * fq + 8 + j]; frq[j] = exp2f(-(float)j * (18.931568569324174f / 8.f)); }
#pragma unroll
            for (int ai = 0; ai < 2; ++ai)
#pragma unroll
                for (int m = 0; m < 4; ++m) { const int pos = pbase + ai * 128 + m; const size_t r = (size_t)(rbase + ai * 128 + m);
                    float y[2][8]; float ss = 0.f;
#pragma unroll
                    for (int bj = 0; bj < 2; ++bj)
#pragma unroll
                        for (int j = 0; j < 8; ++j) { y[bj][j] = acc[ai][bj][m][j >> 2][j & 3]; ss += y[bj][j] * y[bj][j]; }
                    ss += __shfl_xor(ss, 16); ss += __shfl_xor(ss, 32);
                    const float rs = rsqrtf(ss * (1.f / 64.f) + EPS);
#pragma unroll
                    for (int bj = 0; bj < 2; ++bj)
#pragma unroll
                        for (int j = 0; j < 8; ++j) y[bj][j] *= rs * gv[bj][j];
                    if (fq == 0) {
#pragma unroll
                        for (int j = 0; j < 8; ++j) { float s, c; sincos_rev((float)pos * frq[j], s, c); const float x1 = y[0][j], x2 = y[1][j]; y[0][j] = x1 * c - x2 * s; y[1][j] = x2 * c + x1 * s; } }
                    const size_t o = r * 512 + gi * 64 + 16 * fq;
                    if (sec == 4) { u32x4 w0, w1;
                        w0.x = pk_bf16(y[0][0] * C2, y[0][1] * C2); w0.y = pk_bf16(y[0][2] * C2, y[0][3] * C2); w0.z = pk_bf16(y[0][4] * C2, y[0][5] * C2); w0.w = pk_bf16(y[0][6] * C2, y[0][7] * C2);
                        w1.x = pk_bf16(y[1][0] * C2, y[1][1] * C2); w1.y = pk_bf16(y[1][2] * C2, y[1][3] * C2); w1.z = pk_bf16(y[1][4] * C2, y[1][5] * C2); w1.w = pk_bf16(y[1][6] * C2, y[1][7] * C2);
                        *(u32x4*)(DQ + o) = w0; *(u32x4*)(DQ + o + 8) = w1;
                    } else { u32x4 w0, w1;
                        w0.x = pk_bf16(y[0][0], y[0][1]); w0.y = pk_bf16(y[0][2], y[0][3]); w0.z = pk_bf16(y[0][4], y[0][5]); w0.w = pk_bf16(y[0][6], y[0][7]);
                        w1.x = pk_bf16(y[1][0], y[1][1]); w1.y = pk_bf16(y[1][2], y[1][3]); w1.z = pk_bf16(y[1][4], y[1][5]); w1.w = pk_bf16(y[1][6], y[1][7]);
                        *(u32x4*)(DK + o) = w0; *(u32x4*)(DK + o + 8) = w1;
                        *(f32x4*)(outK + o) = (f32x4){y[0][0], y[0][1], y[0][2], y[0][3]}; *(f32x4*)(outK + o + 4) = (f32x4){y[0][4], y[0][5], y[0][6], y[0][7]};
                        *(f32x4*)(outK + o + 8) = (f32x4){y[1][0], y[1][1], y[1][2], y[1][3]}; *(f32x4*)(outK + o + 12) = (f32x4){y[1][4], y[1][5], y[1][6], y[1][7]}; } }
        } else {
            const int cb = 256 * half + 32 * wc + 8 * fq;
#pragma unroll
            for (int ai = 0; ai < 2; ++ai)
#pragma unroll
                for (int m = 0; m < 4; ++m) { const size_t r = (size_t)(rbase + ai * 128 + m);
#pragma unroll
                    for (int bj = 0; bj < 2; ++bj) { const f32x4 v0 = acc[ai][bj][m][0], v1 = acc[ai][bj][m][1]; u32x4 w;
                        w.x = pk_bf16(v0[0], v0[1]); w.y = pk_bf16(v0[2], v0[3]); w.z = pk_bf16(v1[0], v1[1]); w.w = pk_bf16(v1[2], v1[3]);
                        const size_t o = r * 512 + cb + 128 * bj; *(u32x4*)(DV + o) = w; *(f32x4*)(outV + o) = v0; *(f32x4*)(outV + o + 4) = v1; } }
        }
    }
};
struct EpiRes {
    static constexpr bool PERM = true, AFTER_DRAIN = false, APERM = false;
    const float* base; float* out;
    __device__ __forceinline__ void operator()(const f32x4 (&acc)[2][2][4][2], const Unit& u, int wr, int wc, int fr, int fq) const {
        const int cb = u.pn * BM + 32 * wc + 8 * fq;
#pragma unroll
        for (int ai = 0; ai < 2; ++ai)
#pragma unroll
            for (int m = 0; m < 4; ++m) { const size_t r = (size_t)(u.pm * BM + wr * 64 + fr + ai * 128 + m * 16);
#pragma unroll
                for (int bj = 0; bj < 2; ++bj)
#pragma unroll
                    for (int n = 0; n < 2; ++n) { const size_t o = r * 1024 + cb + 128 * bj + 4 * n; *(f32x4*)(out + o) = *(const f32x4*)(base + o) + acc[ai][bj][m][n]; } }
    }
};
template <class Epi, class Sched, bool ALIGN_EPI = false, bool SP2 = false>
__device__ __forceinline__ void gemm_phase(PG8_LAS unsigned char* lds, const Gemm g, const Sched& S, const Epi& E) {
    const int tid = threadIdx.x, wid = __builtin_amdgcn_readfirstlane(tid >> 6), lane = tid & 63, wr = wid >> 2, wc = wid & 3, fr = lane & 15, fq = lane >> 4;
    const int K = g.K, nt = K / BK;
    unsigned voffA[2], voffB[2];
#pragma unroll
    for (int i = 0; i < 2; ++i) { int R, C; stage_rc(tid * 16 + i * 8192, R, C); const int Rb = Epi::PERM ? ((R & ~31) + perm32(R & 31)) : R;
        const int Ra = Epi::APERM ? ((R & 64) | ((R & 15) << 2) | ((R >> 4) & 3)) : R;
        voffA[i] = (unsigned)(Ra * K + C) * 2u; voffB[i] = (unsigned)(Rb * K + C) * 2u; }
    const size_t kstep = (size_t)(BK * 2);
    const size_t hstep = (size_t)HALF * K * 2;
    const size_t tstep = 2 * hstep;
    const unsigned ldsw = (unsigned)wid * 1024u;
    const int aoff = lds_byte(wr * 64 + fr, fq * 8), boff = lds_byte(wc * 32 + fr, fq * 8);
#define PG8_SA(b, h) (((b) * 2 + (h)) * HTB)
#define PG8_SB(b, h) ((4 + (b) * 2 + (h)) * HTB)
#define PG8_STAGE(bufoff, gbase, voff) do { _Pragma("unroll") for (int _i = 0; _i < 2; ++_i) \
        __builtin_amdgcn_global_load_lds((const unsigned*)((const char*)(gbase) + (voff)[_i]), (PG8_LAS unsigned*)(lds + (bufoff) + ldsw + _i * 8192), 16, 0, 0); } while (0)
#define PG8_LDA(dst, b, h) do { _Pragma("unroll") for (int m = 0; m < 4; ++m) _Pragma("unroll") for (int k = 0; k < 2; ++k) dst[m][k] = *(const PG8_LAS bf16x8*)(lds + PG8_SA(b, h) + aoff + m * 2048 + k * 1024); } while (0)
#define PG8_LDB(dst, b, h) do { _Pragma("unroll") for (int n = 0; n < 2; ++n) _Pragma("unroll") for (int k = 0; k < 2; ++k) dst[n][k] = *(const PG8_LAS bf16x8*)(lds + PG8_SB(b, h) + boff + n * 2048 + k * 1024); } while (0)
#define PG8_MMA(ai, bj, At, Bt) do { __builtin_amdgcn_s_setprio(1); _Pragma("unroll") for (int m = 0; m < 4; ++m) _Pragma("unroll") for (int n = 0; n < 2; ++n) _Pragma("unroll") for (int k = 0; k < 2; ++k) \
        acc[ai][bj][m][n] = __builtin_amdgcn_mfma_f32_16x16x32_bf16(Bt[n][k], At[m][k], acc[ai][bj][m][n], 0, 0, 0); __builtin_amdgcn_s_setprio(0); } while (0)
#define PG8_WAIT_V(n) asm volatile("s_waitcnt vmcnt(" #n ")" ::: "memory")
#define PG8_WAIT_L(n) asm volatile("s_waitcnt lgkmcnt(" #n ")" ::: "memory")
#define PG8_BAR __builtin_amdgcn_s_barrier()
#define PG8_SCHED __builtin_amdgcn_sched_barrier(0)
    Unit cur, nxt; int ui = 0;
    if (!S.next(0, cur)) return;
    f32x4 acc[2][2][4][2];
#pragma unroll
    for (int a = 0; a < 2; ++a)
#pragma unroll
        for (int b = 0; b < 2; ++b)
#pragma unroll
            for (int m = 0; m < 4; ++m)
#pragma unroll
                for (int n = 0; n < 2; ++n) acc[a][b][m][n] = (f32x4){0.f, 0.f, 0.f, 0.f};
    bf16x8 At[4][2], B0[2][2], B1[2][2];
    const char* cA = (const char*)g.A + (size_t)cur.pm * tstep; const char* cB = (const char*)g.Bt + (size_t)cur.pn * tstep;
    S.a_ready(cur);
    if constexpr (SP2) {
        PG8_STAGE(PG8_SB(0, 0), cB, voffB); PG8_STAGE(PG8_SB(0, 1), cB + hstep, voffB); PG8_STAGE(PG8_SA(0, 0), cA, voffA); PG8_STAGE(PG8_SA(0, 1), cA + hstep, voffA);
        if (wr == 1) PG8_BAR;
        PG8_WAIT_V(2); PG8_BAR;
        PG8_STAGE(PG8_SB(1, 0), cB + kstep, voffB); PG8_STAGE(PG8_SA(1, 0), cA + kstep, voffA); PG8_STAGE(PG8_SB(1, 1), cB + hstep + kstep, voffB);
        PG8_WAIT_V(6); PG8_BAR;
    } else {
        PG8_STAGE(PG8_SB(0, 0), cB, voffB); PG8_STAGE(PG8_SA(0, 0), cA, voffA); PG8_STAGE(PG8_SB(0, 1), cB + hstep, voffB); PG8_STAGE(PG8_SA(0, 1), cA + hstep, voffA);
        if (wr == 1) PG8_BAR;
        PG8_WAIT_V(4); PG8_BAR;
        PG8_STAGE(PG8_SB(1, 0), cB + kstep, voffB); PG8_STAGE(PG8_SA(1, 0), cA + kstep, voffA); PG8_STAGE(PG8_SB(1, 1), cB + hstep + kstep, voffB);
        PG8_WAIT_V(6); PG8_BAR;
    }
    for (;;) {
        const bool has_next = S.next(ui + 1, nxt);
        const char* nA = has_next ? (const char*)g.A + (size_t)nxt.pm * tstep : cA; const char* nB = has_next ? (const char*)g.Bt + (size_t)nxt.pn * tstep : cB;
        for (int t = 0; t < nt; t += 2) {
            const bool last = (t == nt - 2);
            const char* a1 = cA + (size_t)(t + 1) * kstep;
            const char* a2 = last ? nA : cA + (size_t)(t + 2) * kstep; const char* b2 = last ? nB : cB + (size_t)(t + 2) * kstep;
            const char* a3 = a2 + kstep; const char* b3 = b2 + kstep;
            if (last && has_next) S.a_ready(nxt);
            if constexpr (SP2) {
            PG8_LDB(B0, 0, 0); PG8_LDB(B1, 0, 1); PG8_SCHED; PG8_LDA(At, 0, 0); PG8_STAGE(PG8_SA(1, 1), a1 + hstep, voffA);
            PG8_WAIT_V(8); PG8_WAIT_L(0); PG8_BAR; PG8_MMA(0, 0, At, B0); PG8_MMA(0, 1, At, B1); PG8_BAR; PG8_SCHED;
            PG8_LDA(At, 0, 1); PG8_STAGE(PG8_SB(0, 0), b2, voffB); PG8_STAGE(PG8_SB(0, 1), b2 + hstep, voffB); PG8_STAGE(PG8_SA(0, 0), a2, voffA);
            PG8_WAIT_V(8); PG8_WAIT_L(0); PG8_BAR; PG8_MMA(1, 0, At, B0); PG8_MMA(1, 1, At, B1); PG8_BAR; PG8_SCHED;
            PG8_LDB(B0, 1, 0); PG8_LDB(B1, 1, 1); PG8_SCHED; PG8_LDA(At, 1, 0); PG8_STAGE(PG8_SA(0, 1), a2 + hstep, voffA);
            PG8_WAIT_V(8); PG8_WAIT_L(0); PG8_BAR; PG8_MMA(0, 0, At, B0); PG8_MMA(0, 1, At, B1); PG8_BAR; PG8_SCHED;
            PG8_LDA(At, 1, 1); PG8_STAGE(PG8_SB(1, 0), b3, voffB); PG8_STAGE(PG8_SB(1, 1), b3 + hstep, voffB); PG8_STAGE(PG8_SA(1, 0), a3, voffA);
            PG8_WAIT_V(8); PG8_WAIT_L(0); PG8_BAR; PG8_MMA(1, 0, At, B0); PG8_MMA(1, 1, At, B1); PG8_BAR; PG8_SCHED;
            } else {
            PG8_LDB(B0, 0, 0); PG8_SCHED; PG8_LDA(At, 0, 0); PG8_STAGE(PG8_SA(1, 1), a1 + hstep, voffA);
            PG8_WAIT_L(8); PG8_BAR; PG8_WAIT_L(0); PG8_MMA(0, 0, At, B0); PG8_BAR; PG8_SCHED;
            PG8_LDB(B1, 0, 1); PG8_STAGE(PG8_SB(0, 0), b2, voffB);
            PG8_BAR; PG8_WAIT_L(0); PG8_MMA(0, 1, At, B1); PG8_BAR;
            PG8_LDA(At, 0, 1); PG8_STAGE(PG8_SA(0, 0), a2, voffA);
            PG8_BAR; PG8_WAIT_L(0); PG8_MMA(1, 0, At, B0); PG8_BAR; PG8_SCHED;
            PG8_STAGE(PG8_SB(0, 1), b2 + hstep, voffB);
            PG8_WAIT_V(6); PG8_BAR; PG8_MMA(1, 1, At, B1); PG8_BAR;
            PG8_LDB(B0, 1, 0); PG8_SCHED; PG8_LDA(At, 1, 0); PG8_STAGE(PG8_SA(0, 1), a2 + hstep, voffA);
            PG8_WAIT_L(8); PG8_BAR; PG8_WAIT_L(0); PG8_MMA(0, 0, At, B0); PG8_BAR; PG8_SCHED;
            PG8_LDB(B1, 1, 1); PG8_STAGE(PG8_SB(1, 0), b3, voffB);
            PG8_BAR; PG8_WAIT_L(0); PG8_MMA(0, 1, At, B1); PG8_BAR;
            PG8_LDA(At, 1, 1); PG8_STAGE(PG8_SA(1, 0), a3, voffA);
            PG8_BAR; PG8_WAIT_L(0); PG8_MMA(1, 0, At, B0); PG8_BAR; PG8_SCHED;
            PG8_STAGE(PG8_SB(1, 1), b3 + hstep, voffB);
            PG8_WAIT_V(6); PG8_BAR; PG8_MMA(1, 1, At, B1); PG8_BAR;
            }
        }
        if constexpr (ALIGN_EPI) { if (wr == 0) PG8_BAR; }
        if constexpr (!Epi::AFTER_DRAIN) { E(acc, cur, wr, wc, fr, fq); S.done(cur); }
        if (!has_next) break;
#pragma unroll
        for (int a = 0; a < 2; ++a)
#pragma unroll
            for (int b = 0; b < 2; ++b)
#pragma unroll
                for (int m = 0; m < 4; ++m)
#pragma unroll
                    for (int n = 0; n < 2; ++n) acc[a][b][m][n] = (f32x4){0.f, 0.f, 0.f, 0.f};
        cur = nxt; cA = nA; cB = nB; ++ui;
        if constexpr (ALIGN_EPI) { if (wr == 1) PG8_BAR; }
    }
    PG8_WAIT_V(0);
    if constexpr (!ALIGN_EPI) { if (wr == 0) PG8_BAR; }
    PG8_BAR;
    if constexpr (Epi::AFTER_DRAIN) { E.fused(acc, cur, wr, wc, fr, fq, lds, wid, lane); S.done(cur); }
#undef PG8_SA
#undef PG8_SB
#undef PG8_STAGE
#undef PG8_LDA
#undef PG8_LDB
#undef PG8_MMA
#undef PG8_WAIT_V
#undef PG8_WAIT_L
#undef PG8_BAR
#undef PG8_SCHED
}
}

#define XB_TMO      128
#define XB_XCNT(j)  (256  + 64 * (j))
#define XB_XSUB(j)  (1280 + 64 * (j))
#define XB_XGEN(j)  (2304 + 64 * (j))
#define XB_TOP      3328
#define XB_TOPGEN   3392
#define XCD_BAR_WORDS 3456
#define XB_SPIN_CAP (1u << 18)

__device__ __forceinline__ unsigned xb_ld(unsigned* p)              { return __hip_atomic_load(p, __ATOMIC_RELAXED, __HIP_MEMORY_SCOPE_AGENT); }
__device__ __forceinline__ unsigned xb_add(unsigned* p, unsigned v) { return __hip_atomic_fetch_add(p, v, __ATOMIC_RELAXED, __HIP_MEMORY_SCOPE_AGENT); }
__device__ __forceinline__ unsigned xb_xcc_id() { return (unsigned)__builtin_amdgcn_s_getreg((3 << 11) | 20) & 0xFu; }
#define XB_SPIN(cond, bar) do { unsigned _sp = 0; while (cond) { __builtin_amdgcn_s_sleep(1); \
    if ((++_sp & 255u) == 0u) { if (xb_ld(&(bar)[XB_TMO])) break; if (_sp > XB_SPIN_CAP) { atomicAdd(&(bar)[XB_TMO], 1u); break; } } } } while (0)

struct XcdBarrier {
    unsigned* bar; unsigned x;
    volatile LAS unsigned* st;
};

__device__ __forceinline__ XcdBarrier xcd_barrier_post(unsigned* bar, volatile LAS unsigned* st) {
    XcdBarrier b; b.bar = bar; b.x = xb_xcc_id(); b.st = st;
    if (threadIdx.x == 0) (void)xb_add(&bar[XB_XCNT(b.x)], 1u);
    return b;
}
__device__ __forceinline__ void xcd_barrier_complete(unsigned* bar, unsigned x, unsigned& nloc, unsigned& nx) {
    const unsigned G = gridDim.x * gridDim.y * gridDim.z;
    unsigned sum, cnt, mine, sp = 0u;
    for (;;) {
        sum = 0u; cnt = 0u; mine = 0u;
#pragma unroll
        for (unsigned j = 0; j < 16; ++j) { const unsigned c = xb_ld(&bar[XB_XCNT(j)]); sum += c; cnt += (c > 0u) ? 1u : 0u; mine = (j == x) ? c : mine; }
        if (sum == G) break;
        __builtin_amdgcn_s_sleep(1);
        if ((++sp & 255u) == 0u) { if (xb_ld(&bar[XB_TMO])) break; if (sp > XB_SPIN_CAP) { atomicAdd(&bar[XB_TMO], 1u); break; } }
    }
    nloc = mine > 0u ? mine : 1u; nx = cnt > 0u ? cnt : 1u;
}

__device__ __forceinline__ void xcd_barrier(const XcdBarrier& b) {
    asm volatile("s_waitcnt vmcnt(0)" ::: "memory");
    __syncthreads();
    if (threadIdx.x == 0) {
        unsigned* bar = b.bar;
        __builtin_amdgcn_s_waitcnt(0);
        unsigned nloc = b.st[0], nx = b.st[1];
        if (nloc == 0u) { xcd_barrier_complete(bar, b.x, nloc, nx); b.st[0] = nloc; b.st[1] = nx; }
        const unsigned old = xb_add(&bar[XB_XSUB(b.x)], 1u);
        const unsigned gen = old / nloc;
        if (old + 1u == (gen + 1u) * nloc) {
            __builtin_amdgcn_fence(__ATOMIC_RELEASE, "agent");
            asm volatile("s_waitcnt vmcnt(0)" ::: "memory");
            const unsigned og = xb_add(&bar[XB_TOP], 1u);
            const unsigned tg = og / nx;
            if (og + 1u == (tg + 1u) * nx) xb_add(&bar[XB_TOPGEN], 1u);
            else XB_SPIN(xb_ld(&bar[XB_TOPGEN]) == tg, bar);
            __builtin_amdgcn_fence(__ATOMIC_ACQUIRE, "agent");
            xb_add(&bar[XB_XGEN(b.x)], 1u);
            asm volatile("s_waitcnt vmcnt(0)" ::: "memory");
        } else {
            XB_SPIN(xb_ld(&bar[XB_XGEN(b.x)]) == gen, bar);
            __builtin_amdgcn_fence(__ATOMIC_ACQUIRE, "agent");
            asm volatile("s_waitcnt vmcnt(0)" ::: "memory");
        }
    }
    __syncthreads();
}
constexpr int NWAVES = 8, NTHR = 512;
constexpr int RING_OFF = 0, RING_BYTES = 131072, LDSCTL_OFF = RING_BYTES, MISC_OFF = LDSCTL_OFF + 320, LDS_BYTES = 147456;
constexpr size_t CTL_ZERO_BYTES = 32768;
constexpr int CW_TMO = 0, CW_BAR = 4096;
enum { F_PROJ = 1, F_ATTN = 2, F_RET = 4, F_MERGE = 8, F_OUT = 16, F_DEC = 32, F_ALL = 63 };
typedef unsigned v4u __attribute__((ext_vector_type(4)));
typedef float f32x4 __attribute__((ext_vector_type(4)));
typedef float f32x16 __attribute__((ext_vector_type(16)));
typedef short bf16x8 __attribute__((ext_vector_type(8)));
typedef short s16x4 __attribute__((ext_vector_type(4)));
#define LDS_WAIT() asm volatile("s_waitcnt lgkmcnt(0)" ::: "memory")
__device__ __forceinline__ unsigned pk2(float lo, float hi) { return (unsigned)f2bf(lo) | ((unsigned)f2bf(hi) << 16); }
__device__ __forceinline__ int crow16(int r, int hi) { return (r & 3) + 8 * (r >> 2) + 4 * hi; }

__device__ __forceinline__ int wt1_phys(int L) {
    const int pn = L >> 8, sec = pn >> 1, q = L & 255; int p = q;
    if (sec <= 1) p = (q & 63) | (((q >> 7) & 1) << 6) | (((q >> 6) & 1) << 7);
    else if (sec == 4 || sec == 5) p = (((q >> 3) & 1) << 7) | (((q >> 6) & 3) << 5) | (((q >> 4) & 3) << 3) | (q & 7);
    return (pn << 8) | p;
}
template <bool PERMUTE> __device__ __forceinline__ void p0_transpose_item(const float* W, int K, int N, u16* WT, LAS float* scr, int item, int lane) {
    const int nblk = N / 32, kb = item / nblk, nb = item % nblk, k0 = 64 * kb, n0 = 32 * nb;
#pragma unroll 8
    for (int i = 0; i < 32; ++i) { const int kk = 2 * i + (lane >> 5); scr[kk * 33 + (lane & 31)] = W[(size_t)(k0 + kk) * N + n0 + (lane & 31)]; }
    LDS_WAIT(); asm volatile("" ::: "memory");
    const int c = lane & 7;
#pragma unroll
    for (int j = 0; j < 4; ++j) { const int n = (lane >> 3) + 8 * j; const LAS float* s = scr + (8 * c) * 33 + n;
        v4u o; o.x = pk2(s[0 * 33], s[1 * 33]); o.y = pk2(s[2 * 33], s[3 * 33]); o.z = pk2(s[4 * 33], s[5 * 33]); o.w = pk2(s[6 * 33], s[7 * 33]);
        const int row = PERMUTE ? wt1_phys(n0 + n) : (n0 + n);
        *(v4u*)(WT + (size_t)row * K + k0 + 8 * c) = o; }
    LDS_WAIT(); asm volatile("" ::: "memory");
}
__device__ __forceinline__ void xn_row(const float* xrow, const float* g, u16* orow, int lane) {
    const f32x4* xr = (const f32x4*)xrow + lane; f32x4 v[4]; float s = 0.f;
#pragma unroll
    for (int j = 0; j < 4; ++j) { v[j] = xr[64 * j]; s += (v[j].x * v[j].x + v[j].y * v[j].y) + (v[j].z * v[j].z + v[j].w * v[j].w); }
    const float rs = rsqrtf(wave_sum(s) * (1.f / DM) + EPS);
    unsigned long long* o8 = (unsigned long long*)orow + lane;
#pragma unroll
    for (int j = 0; j < 4; ++j) { const f32x4 gg = ((const f32x4*)g)[lane + 64 * j];
        o8[64 * j] = (unsigned long long)pk2(v[j].x * rs * gg.x, v[j].y * rs * gg.y) | ((unsigned long long)pk2(v[j].z * rs * gg.z, v[j].w * rs * gg.w) << 32); }
}
template <bool NORM, bool RES, bool USE_WT = false> __device__ __forceinline__ void dec_proj(const float* A, const float* g, const float* W, int N, float* out, const float* R, LAS float* sm, int first_cb, int G, const u16* WT = nullptr) {
    int t = threadIdx.x; asm volatile("" : "+v"(t));
    const int wave = t >> 6, lane = t & 63, ncb = N / 16;
    if (first_cb >= ncb) return;
    for (int r = wave; r < 32; r += 8) { float v[16]; float s = 0.f;
#pragma unroll
        for (int j = 0; j < 16; ++j) { v[j] = A[(size_t)r * 1024 + lane + 64 * j]; s += v[j] * v[j]; }
        const float rs = NORM ? rsqrtf(wave_sum(s) * (1.f / 1024.f) + EPS) : 1.f;
#pragma unroll
        for (int j = 0; j < 16; ++j) sm[r * 1024 + lane + 64 * j] = NORM ? v[j] * rs * g[lane + 64 * j] : v[j]; }
    __syncthreads();
    const int col = t & 15, ks = t >> 4;
    for (int cb = first_cb; cb < ncb; cb += (USE_WT ? ncb : G)) { const int n0 = cb * 16;
        float acc[32];
#pragma unroll
        for (int i = 0; i < 32; ++i) acc[i] = 0.f;
        if constexpr (USE_WT) {
            float wv[32]; const v4u* wp = (const v4u*)(WT + (size_t)(n0 + col) * 1024 + ks * 32);
#pragma unroll
            for (int q = 0; q < 4; ++q) { const v4u w4 = wp[q];
                wv[8 * q] = bf2f((u16)(w4.x & 0xffff)); wv[8 * q + 1] = bf2f((u16)(w4.x >> 16)); wv[8 * q + 2] = bf2f((u16)(w4.y & 0xffff)); wv[8 * q + 3] = bf2f((u16)(w4.y >> 16));
                wv[8 * q + 4] = bf2f((u16)(w4.z & 0xffff)); wv[8 * q + 5] = bf2f((u16)(w4.z >> 16)); wv[8 * q + 6] = bf2f((u16)(w4.w & 0xffff)); wv[8 * q + 7] = bf2f((u16)(w4.w >> 16)); }
#pragma unroll
            for (int kk = 0; kk < 32; ++kk) { const int k = ks * 32 + kk;
#pragma unroll
                for (int i = 0; i < 32; ++i) acc[i] += sm[i * 1024 + k] * wv[kk]; }
        } else {
            for (int kk = 0; kk < 32; ++kk) { const int k = ks * 32 + kk; const float w = W[(size_t)k * N + n0 + col];
#pragma unroll
                for (int i = 0; i < 32; ++i) acc[i] += sm[i * 1024 + k] * w; } }
#pragma unroll
        for (int i = 0; i < 32; ++i) { acc[i] += __shfl_xor(acc[i], 16); acc[i] += __shfl_xor(acc[i], 32); }
        __syncthreads();
        LAS float* red = sm;
        if (lane < 16) {
#pragma unroll
            for (int i = 0; i < 32; ++i) red[(wave * 32 + i) * 16 + col] = acc[i]; }
        __syncthreads();
        { const int i = t >> 4, c = t & 15; float s = 0.f;
#pragma unroll
          for (int q = 0; q < 8; ++q) s += red[(q * 32 + i) * 16 + c];
          const size_t o = (size_t)i * N + n0 + c; out[o] = s + (RES ? R[o] : 0.f); }
        __syncthreads();
        if (!USE_WT && cb + G < ncb) {
            for (int r = wave; r < 4; r += 8) { float v[16]; float s = 0.f;
#pragma unroll
                for (int j = 0; j < 16; ++j) { v[j] = A[(size_t)r * 1024 + lane + 64 * j]; s += v[j] * v[j]; }
                const float rs = NORM ? rsqrtf(wave_sum(s) * (1.f / 1024.f) + EPS) : 1.f;
#pragma unroll
                for (int j = 0; j < 16; ++j) sm[r * 1024 + lane + 64 * j] = NORM ? v[j] * rs * g[lane + 64 * j] : v[j]; }
            __syncthreads(); }
    }
}
__device__ __forceinline__ void dec_proj_in(const float* xs, const float* g, const float* W, float* ZS4, LAS float* sm, int bx, const float* x, u16* XN, int gw, int NGW) {
    int t = threadIdx.x; asm volatile("" : "+v"(t));
    const int wave = t >> 6, lane = t & 63, n0 = 64 * (bx >> 2), kq = bx & 3, k0 = 256 * kq;
    float wv[32];
#pragma unroll
    for (int kk = 0; kk < 32; ++kk) wv[kk] = W[(size_t)(k0 + 32 * wave + kk) * NZ + n0 + lane];
    { f32x4 v[4][4];
#pragma unroll
      for (int q = 0; q < 4; ++q)
#pragma unroll
          for (int j = 0; j < 4; ++j) v[q][j] = ((const f32x4*)(xs + (size_t)(wave + 8 * q) * 1024))[lane + 64 * j];
      for (int m = gw; m < M; m += NGW) xn_row(x + (size_t)m * DM, g, XN + (size_t)m * DM, lane);
      f32x4 gg[4];
#pragma unroll
      for (int j = 0; j < 4; ++j) gg[j] = ((const f32x4*)g)[lane + 64 * j];
#pragma unroll
      for (int q = 0; q < 4; ++q) { float s = 0.f;
#pragma unroll
          for (int j = 0; j < 4; ++j) s += (v[q][j].x * v[q][j].x + v[q][j].y * v[q][j].y) + (v[q][j].z * v[q][j].z + v[q][j].w * v[q][j].w);
          const float rs = rsqrtf(wave_sum(s) * (1.f / 1024.f) + EPS);
          f32x4 o = kq == 0 ? v[q][0] * gg[0] : kq == 1 ? v[q][1] * gg[1] : kq == 2 ? v[q][2] * gg[2] : v[q][3] * gg[3];
          ((LAS f32x4*)(sm + (wave + 8 * q) * 256))[lane] = o * rs; } }
    __syncthreads();
    float acc[32];
#pragma unroll
    for (int i = 0; i < 32; ++i) acc[i] = 0.f;
#pragma unroll
    for (int k4 = 0; k4 < 8; ++k4)
#pragma unroll
        for (int i = 0; i < 32; ++i) { const f32x4 a = *(const LAS f32x4*)(sm + i * 256 + 32 * wave + 4 * k4);
            acc[i] += a.x * wv[4 * k4] + a.y * wv[4 * k4 + 1] + a.z * wv[4 * k4 + 2] + a.w * wv[4 * k4 + 3]; }
    LAS float* red = sm + 8192;
#pragma unroll
    for (int i = 0; i < 32; ++i) red[(wave * 32 + i) * 64 + lane] = acc[i];
    __syncthreads();
#pragma unroll
    for (int q = 0; q < 4; ++q) { const int idx = t + 512 * q, i = idx >> 6, c = idx & 63; float s = 0.f;
#pragma unroll
        for (int w = 0; w < 8; ++w) s += red[(w * 32 + i) * 64 + c];
        ZS4[(size_t)(kq * 32 + i) * NZ + n0 + c] = s; }
    __syncthreads();
}
__device__ __forceinline__ void dec_epi(int b, const float* ZS, const float* gq, const float* gk, float* dec, float* outK, float* outV) {
    const int t = threadIdx.x; const float* z0 = ZS + (size_t)b * 4096; const float pos = (float)PAST;
#define z(i_) (z0[(i_)] + z0[(i_) + 32 * 4096] + z0[(i_) + 2 * 32 * 4096] + z0[(i_) + 3 * 32 * 4096])
    { const int h = t >> 7, d = t & 127, i = d & 63; const float fr = exp2f(-(float)i * (13.287712379549449f / 64.f));
      float s, c; sincos_rev(pos * fr, s, c);
      const float q1 = z(h * 128 + i), q2 = z(h * 128 + 64 + i), k1 = z(512 + h * 128 + i), k2 = z(512 + h * 128 + 64 + i);
      dec[D_RQS + b * 512 + t] = d < 64 ? q1 * c - q2 * s : q2 * c + q1 * s;
      dec[D_RKS + b * 512 + t] = (d < 64 ? k1 * c - k2 * s : k2 * c + k1 * s) * 0.08838834764831845f;
      dec[D_RVS + b * 512 + t] = z(1024 + t);
      dec[D_GS + b * 1024 + t] = silu(z(1536 + t)); dec[D_GS + b * 1024 + 512 + t] = silu(z(3584 + t)); }
    { const int d = t & 63; const float fr = exp2f(-(float)(d & 7) * (18.931568569324174f / 8.f));
      float s, c; sincos_rev(pos * fr, s, c);
      const float zq = z(2048 + t), zk = z(2560 + t);
      const float yq = zq * rsqrtf(wave_sum(zq * zq) * (1.f / 64.f) + EPS) * gq[d], yk = zk * rsqrtf(wave_sum(zk * zk) * (1.f / 64.f) + EPS) * gk[d];
      const float pq = __shfl_xor(yq, 8), pk = __shfl_xor(yk, 8);
      const float oq = d < 8 ? yq * c - pq * s : (d < 16 ? yq * c + pq * s : yq);
      const float ok = d < 8 ? yk * c - pk * s : (d < 16 ? yk * c + pk * s : yk);
      dec[D_QS + b * 512 + t] = oq * C2; outK[b * 512 + t] = ok; outV[b * 512 + t] = z(3072 + t); }
}
#undef z
__device__ __forceinline__ void dec_ret(int bh, const float* S, const float* dec, const float* g_ret, float* Sout, float* US, LAS float* sm) {
    const int b = bh >> 2, h = bh & 3, t = threadIdx.x, e = t & 127, dq = t >> 7; const float gam = 1.0f - exp2f(-5.0f - (float)h);
    LAS float* qs = sm; LAS float* ks = sm + 128; LAS float* part = sm + 256; LAS float* red = sm + 768;
    const float* Sp = S + (size_t)bh * 16384; float* So = Sout + (size_t)bh * 16384;
    float sv[32];
#pragma unroll
    for (int dd = 0; dd < 32; ++dd) sv[dd] = Sp[(dq * 32 + dd) * 128 + e];
    const float qv = dec[D_RQS + b * 512 + h * 128 + e], kv = dec[D_RKS + b * 512 + h * 128 + e], v = dec[D_RVS + b * 512 + h * 128 + e];
    const float gt = dec[D_GS + b * 1024 + h * 128 + e], gr = g_ret[e];
    if (t < 128) { qs[t] = qv; ks[t] = kv; }
    const float wqk = wave_sum(qv * kv); if (t < 128 && (t & 63) == 0) red[2 + (t >> 6)] = wqk;
    __syncthreads();
    float qS = 0.f;
#pragma unroll
    for (int dd = 0; dd < 32; ++dd) { const int d = dq * 32 + dd; qS += qs[d] * sv[dd]; So[d * 128 + e] = gam * sv[dd] + ks[d] * v; }
    part[dq * 128 + e] = qS;
    __syncthreads();
    float o = 0.f;
    if (t < 128) { const float qk = red[2] + red[3];
        o = qk * v + gam * (part[e] + part[128 + e] + part[256 + e] + part[384 + e]);
        const float ws = wave_sum(o * o); if ((t & 63) == 0) red[t >> 6] = ws; }
    __syncthreads();
    if (t < 128) { const float rs = rsqrtf((red[0] + red[1]) * (1.f / 128.f) + EPS); US[b * 1024 + h * 128 + e] = o * rs * gr * gt; }
    __syncthreads();
}
template <int CTRL> __device__ __forceinline__ float dppf(float v) { return __builtin_bit_cast(float, __builtin_amdgcn_update_dpp(0, __builtin_bit_cast(int, v), CTRL, 0xf, 0xf, true)); }
#define DPP_X1 0xB1
#define DPP_X2 0x4E
#define DPP_HM 0x141
#define DPP_R8 0x128
__device__ __forceinline__ void dec_comb(int bh, const float* part, const float* dec, const float* newK, const float* newV, const float* g_diff, float lam, float* US, LAS float* sm) {
    const int b = bh >> 2, h = bh & 3, t = threadIdx.x, e = t & 127;
    LAS float* snew = sm; LAS float* onb = sm + 8; LAS float* red = sm + 8 + 256;
    if (t < 128) { const int c = t >> 6, d = t & 63; const float s = wave_sum(dec[D_QS + b * 512 + (2 * h + c) * 64 + d] * newK[b * 512 + (2 * h + c) * 64 + d]); if (d == 0) snew[c] = s; }
    __syncthreads();
    if (t < 256) { const int c = t >> 7, hc = 2 * h + c; const float vn = newV[b * 512 + h * 128 + e]; float mx = snew[c];
        for (int s = 0; s < NSPLIT; ++s) mx = fmaxf(mx, part[((size_t)(b * NSPLIT + s) * 8 + hc) * PSTR]);
        float L = exp2f(snew[c] - mx), O = L * vn;
        for (int s = 0; s < NSPLIT; ++s) { const float* pp = part + ((size_t)(b * NSPLIT + s) * 8 + hc) * PSTR; const float f = exp2f(pp[0] - mx); L += pp[1] * f; O += pp[2 + e] * f; }
        onb[c * 128 + e] = O / L; }
    __syncthreads();
    float o = 0.f;
    if (t < 128) { o = onb[e] - lam * onb[128 + e]; const float ws = wave_sum(o * o); if ((t & 63) == 0) red[t >> 6] = ws; }
    __syncthreads();
    if (t < 128) { const float rs = rsqrtf((red[0] + red[1]) * (1.f / 128.f) + EPS); US[b * 1024 + 512 + h * 128 + e] = o * rs * g_diff[e] * (1.f - LAM_INIT) * dec[D_GS + b * 1024 + 512 + h * 128 + e]; }
    __syncthreads();
}
#define MFMA32(a, b, c) __builtin_amdgcn_mfma_f32_32x32x16_bf16((a), (b), (c), 0, 0, 0)
template <int OFF> __device__ __forceinline__ void rt_glds(const void* sbase, unsigned voff, unsigned lds_dst) { unsigned keep;
    asm volatile("s_mov_b32 %0, m0\n\ts_mov_b32 m0, %3\n\ts_nop 0\n\tglobal_load_lds_dwordx4 %1, %2 offset:%c4\n\ts_mov_b32 m0, %0" : "=&s"(keep) : "v"(voff), "s"(sbase), "s"(lds_dst - (unsigned)OFF), "i"(OFF) : "memory"); }
__device__ __forceinline__ void rt_stage(const void* sbase, unsigned pitch, unsigned lds_dst, int wave, int lane) {
#pragma unroll
    for (int k = 0; k < 4; ++k) { const int p = wave + 8 * k; const unsigned row = 4 * p + (lane >> 4), ch = (lane & 15) ^ (((lane >> 4) << 2) | (p & 3));
        rt_glds<0>(sbase, row * pitch + ch * 16, (unsigned)__builtin_amdgcn_readfirstlane(lds_dst + p * 1024)); }
}
__device__ __forceinline__ int rt_swz(int row, int ch) { return row * 256 + ((ch ^ (((row & 3) << 2) | ((row >> 2) & 3))) << 4); }
typedef const __attribute__((address_space(3))) bf16x8* rt_p16; typedef unsigned u32x2 __attribute__((ext_vector_type(2))); typedef const __attribute__((address_space(3))) u32x2* rt_p8;
__device__ __forceinline__ void ret_r1x2(const u16* VT, const u16* KTD, float* RA, int t0, int t1, LAS unsigned char* L, int wave, int lane) {
    const unsigned l0 = (unsigned)(uintptr_t)L;
    if (t0 >= 0) { rt_stage(VT + (size_t)t0 * 16384, 256, l0, wave, lane); rt_stage(KTD + (size_t)t0 * 16384, 256, l0 + 32768, wave, lane); }
    if (t1 >= 0) { rt_stage(VT + (size_t)t1 * 16384, 256, l0 + 65536, wave, lane); rt_stage(KTD + (size_t)t1 * 16384, 256, l0 + 98304, wave, lane); }
    asm volatile("s_waitcnt vmcnt(0)" ::: "memory"); __syncthreads();
    const int r = lane & 31, hi = lane >> 5, eb = wave & 3, dbp = wave >> 2;
#pragma unroll
    for (int u = 0; u < 2; ++u) { const int ti = u ? t1 : t0; if (ti < 0) continue;
        const LAS unsigned char* Lv = L + u * 65536; const LAS unsigned char* Lk = Lv + 32768;
        f32x16 a0 = {}, a1 = {};
#pragma unroll
        for (int s = 0; s < 8; ++s) { const bf16x8 a = *(rt_p16)(Lv + rt_swz(eb * 32 + r, 2 * s + hi)), b0 = *(rt_p16)(Lk + rt_swz(dbp * 64 + r, 2 * s + hi)), b1 = *(rt_p16)(Lk + rt_swz(dbp * 64 + 32 + r, 2 * s + hi));
            a0 = MFMA32(a, b0, a0); a1 = MFMA32(a, b1, a1); }
        float* o = RA + (size_t)ti * 16384;
#pragma unroll
        for (int q = 0; q < 16; ++q) { const int e = eb * 32 + crow16(q, hi); o[e * 128 + dbp * 64 + r] = a0[q]; o[e * 128 + dbp * 64 + 32 + r] = a1[q]; } }
    __syncthreads();
}
__device__ __forceinline__ void ret_r3(const u16* RQ, const u16* RK, const u16* VT, const u16* ST, const u16* GATE, const float* g_ret, u16* U, int ti, LAS unsigned char* L, int wave, int lane) {
    const int bh = ti >> 5, c = ti & 31, b = bh >> 2, h = bh & 3, r = lane & 31, hi = lane >> 5, tb = wave & 3, eh = wave >> 2;
    const float lg = log2_gamma(h); const size_t row0 = (size_t)b * SEQ + c * 128; const unsigned l0 = (unsigned)(uintptr_t)L;
    rt_stage(RQ + row0 * 512 + h * 128, 1024, l0, wave, lane); rt_stage(RK + row0 * 512 + h * 128, 1024, l0 + 32768, wave, lane);
    rt_stage(VT + (size_t)ti * 16384, 256, l0 + 65536, wave, lane); rt_stage(ST + (size_t)ti * 16384, 256, l0 + 98304, wave, lane);
    asm volatile("s_waitcnt vmcnt(0)" ::: "memory"); __syncthreads();
    const LAS unsigned char* Lq = L; const LAS unsigned char* Lk = L + 32768; const LAS unsigned char* Lv = L + 65536; const LAS unsigned char* Ls = L + 98304;
    LAS float* red = (LAS float*)(L + 131072 + 8192);
    bf16x8 qf[8];
#pragma unroll
    for (int s = 0; s < 8; ++s) qf[s] = *(rt_p16)(Lq + rt_swz(tb * 32 + r, 2 * s + hi));
    f32x16 o0 = {}, o1 = {};
    for (int jb = 0; jb <= tb; ++jb) {
        f32x16 sT = {};
#pragma unroll
        for (int s = 0; s < 8; ++s) sT = MFMA32(*(rt_p16)(Lk + rt_swz(jb * 32 + r, 2 * s + hi)), qf[s], sT);
        float pw[16];
#pragma unroll
        for (int q = 0; q < 16; ++q) { const int dj = (32 * tb + r) - (32 * jb + crow16(q, hi)); pw[q] = dj >= 0 ? sT[q] * exp2f((float)dj * lg) : 0.f; }
        v4u p0, p1; p0.x = pk2(pw[0], pw[1]); p0.y = pk2(pw[2], pw[3]); p0.z = pk2(pw[4], pw[5]); p0.w = pk2(pw[6], pw[7]);
        p1.x = pk2(pw[8], pw[9]); p1.y = pk2(pw[10], pw[11]); p1.z = pk2(pw[12], pw[13]); p1.w = pk2(pw[14], pw[15]);
        const bf16x8 pb0 = __builtin_bit_cast(bf16x8, p0), pb1 = __builtin_bit_cast(bf16x8, p1);
#pragma unroll
        for (int eb = 0; eb < 2; ++eb) { const int e = eh * 64 + eb * 32 + r;
            const u32x2 l0_ = *(rt_p8)(Lv + rt_swz(e, 4 * jb) + 8 * hi), h0_ = *(rt_p8)(Lv + rt_swz(e, 4 * jb + 1) + 8 * hi), l1_ = *(rt_p8)(Lv + rt_swz(e, 4 * jb + 2) + 8 * hi), h1_ = *(rt_p8)(Lv + rt_swz(e, 4 * jb + 3) + 8 * hi);
            const bf16x8 a0 = __builtin_bit_cast(bf16x8, (v4u){l0_.x, l0_.y, h0_.x, h0_.y}), a1 = __builtin_bit_cast(bf16x8, (v4u){l1_.x, l1_.y, h1_.x, h1_.y});
            if (eb == 0) { o0 = MFMA32(a0, pb0, o0); o0 = MFMA32(a1, pb1, o0); } else { o1 = MFMA32(a0, pb0, o1); o1 = MFMA32(a1, pb1, o1); } }
    }
    { f32x16 x0 = {}, x1 = {};
#pragma unroll
      for (int s = 0; s < 8; ++s) { x0 = MFMA32(*(rt_p16)(Ls + rt_swz(eh * 64 + r, 2 * s + hi)), qf[s], x0); x1 = MFMA32(*(rt_p16)(Ls + rt_swz(eh * 64 + 32 + r, 2 * s + hi)), qf[s], x1); }
      const float qd = exp2f((float)(32 * tb + r + 1) * lg);
#pragma unroll
      for (int q = 0; q < 16; ++q) { o0[q] += qd * x0[q]; o1[q] += qd * x1[q]; } }
    float ss = 0.f;
#pragma unroll
    for (int q = 0; q < 16; ++q) ss += o0[q] * o0[q] + o1[q] * o1[q];
    ss += __shfl_xor(ss, 32);
    if (hi == 0) red[wave * 32 + r] = ss;
    __syncthreads();
    const float rs = rsqrtf((red[wave * 32 + r] + red[(wave ^ 4) * 32 + r]) * (1.f / 128.f) + EPS);
    const size_t row = row0 + tb * 32 + r;
#pragma unroll
    for (int eb = 0; eb < 2; ++eb)
#pragma unroll
        for (int g4 = 0; g4 < 4; ++g4) { const int e = eh * 64 + eb * 32 + 8 * g4 + 4 * hi; const size_t o = row * 1024 + h * 128 + e;
            const uint2 gt = *(const uint2*)(GATE + o); const f32x4 gr = *(const f32x4*)(g_ret + e);
            const float y0 = (eb ? o1[4 * g4] : o0[4 * g4]) * rs * gr[0] * bf2f((u16)(gt.x & 0xffff)), y1 = (eb ? o1[4 * g4 + 1] : o0[4 * g4 + 1]) * rs * gr[1] * bf2f((u16)(gt.x >> 16));
            const float y2 = (eb ? o1[4 * g4 + 2] : o0[4 * g4 + 2]) * rs * gr[2] * bf2f((u16)(gt.y & 0xffff)), y3 = (eb ? o1[4 * g4 + 3] : o0[4 * g4 + 3]) * rs * gr[3] * bf2f((u16)(gt.y >> 16));
            uint2 w; w.x = pk2(y0, y1); w.y = pk2(y2, y3); *(uint2*)(U + o) = w; }
    __syncthreads();
}
namespace p2f {
typedef __attribute__((address_space(3))) const char* lcp;
constexpr int KBUF = 8192, K1OFF = 16384, VOFF = 32768, VBUF = 16384, L_DEC = 65536;
template <int OFF> __device__ __forceinline__ void glds16(const void* sbase, unsigned voff, unsigned lds_dst) { unsigned keep;
    asm volatile("s_mov_b32 %0, m0\n\ts_mov_b32 m0, %3\n\ts_nop 0\n\tglobal_load_lds_dwordx4 %1, %2 offset:%c4\n\ts_mov_b32 m0, %0" : "=&s"(keep) : "v"(voff), "s"(sbase), "s"(lds_dst - (unsigned)OFF), "i"(OFF) : "memory"); }
template <int OFF> __device__ __forceinline__ void glds16_nt(const void* sbase, unsigned voff, unsigned lds_dst) { unsigned keep;
    asm volatile("s_mov_b32 %0, m0\n\ts_mov_b32 m0, %3\n\ts_nop 0\n\tglobal_load_lds_dwordx4 %1, %2 offset:%c4 sc1 nt\n\ts_mov_b32 m0, %0" : "=&s"(keep) : "v"(voff), "s"(sbase), "s"(lds_dst - (unsigned)OFF), "i"(OFF) : "memory"); }
__device__ __forceinline__ s16x4 vtr(lcp p) { typedef short v4i16_t __attribute__((ext_vector_type(4))); return __builtin_bit_cast(s16x4, __builtin_amdgcn_ds_read_tr16_b64_v4i16((__attribute__((address_space(3))) v4i16_t*)p)); }
#define P2_WAIT_BAR(n) do { if ((n) == 10) asm volatile("s_waitcnt vmcnt(10) lgkmcnt(0)\n\ts_barrier" ::: "memory"); else if ((n) == 8) asm volatile("s_waitcnt vmcnt(8) lgkmcnt(0)\n\ts_barrier" ::: "memory"); \
        else if ((n) == 2) asm volatile("s_waitcnt vmcnt(2) lgkmcnt(0)\n\ts_barrier" ::: "memory"); else asm volatile("s_waitcnt vmcnt(0) lgkmcnt(0)\n\ts_barrier" ::: "memory"); } while (0)

typedef float f32x2_t __attribute__((ext_vector_type(2))); typedef __bf16 bf16x2_t __attribute__((ext_vector_type(2)));
__device__ __forceinline__ unsigned cvtpk(float lo, float hi) { const f32x2_t v = {lo, hi}; return __builtin_bit_cast(unsigned, __builtin_convertvector(v, bf16x2_t)); }
template <bool MASK> __device__ __forceinline__ void h1(lcp kbase, const bf16x8 (&qf)[4], float& lsum, float shift, int qrel  , int hi, bf16x8& pb0, bf16x8& pb1, bf16x8& pb2, bf16x8& pb3) {
    typedef const __attribute__((address_space(3))) bf16x8* kp_t;
    bf16x8 kf[8];
#pragma unroll
    for (int d0 = 0; d0 < 4; ++d0) { kf[2 * d0] = *(kp_t)(kbase + d0 * 2048); kf[2 * d0 + 1] = *(kp_t)(kbase + d0 * 2048 + 512); }
    f32x16 S0 = MFMA32(kf[0], qf[0], (f32x16{})), S1 = MFMA32(kf[1], qf[0], (f32x16{}));
#pragma unroll
    for (int d0 = 1; d0 < 4; ++d0) { S0 = MFMA32(kf[2 * d0], qf[d0], S0); S1 = MFMA32(kf[2 * d0 + 1], qf[d0], S1); }
    float ls = 0.f;
#pragma unroll
    for (int r = 0; r < 16; ++r) { S0[r] = __builtin_amdgcn_exp2f(S0[r] - shift); S1[r] = __builtin_amdgcn_exp2f(S1[r] - shift);
        if (MASK) { const int kv = crow16(r, hi); if (kv > qrel) S0[r] = 0.f; if (kv + 32 > qrel) S1[r] = 0.f; }
        ls += S0[r] + S1[r]; }
    lsum += ls;
    v4u w0, w1, w2, w3;
    w0.x = cvtpk(S0[0], S0[1]); w0.y = cvtpk(S0[2], S0[3]); w0.z = cvtpk(S0[4], S0[5]); w0.w = cvtpk(S0[6], S0[7]);
    w1.x = cvtpk(S0[8], S0[9]); w1.y = cvtpk(S0[10], S0[11]); w1.z = cvtpk(S0[12], S0[13]); w1.w = cvtpk(S0[14], S0[15]);
    w2.x = cvtpk(S1[0], S1[1]); w2.y = cvtpk(S1[2], S1[3]); w2.z = cvtpk(S1[4], S1[5]); w2.w = cvtpk(S1[6], S1[7]);
    w3.x = cvtpk(S1[8], S1[9]); w3.y = cvtpk(S1[10], S1[11]); w3.z = cvtpk(S1[12], S1[13]); w3.w = cvtpk(S1[14], S1[15]);
    pb0 = __builtin_bit_cast(bf16x8, w0); pb1 = __builtin_bit_cast(bf16x8, w1); pb2 = __builtin_bit_cast(bf16x8, w2); pb3 = __builtin_bit_cast(bf16x8, w3);
}
#define P2_VLOAD(dst, g) do { _Pragma("unroll") for (int k_ = 0; k_ < 2; ++k_) { dst[2 * k_] = vtr(vbase + ((g) >> 1) * 4096 + (((g) & 1) * 2 + k_) * 1024); dst[2 * k_ + 1] = vtr(vbase + ((g) >> 1) * 4096 + (((g) & 1) * 2 + k_) * 1024 + 512); } } while (0)
#define P2_VFR(src, k) (bf16x8){src[2 * (k)][0], src[2 * (k)][1], src[2 * (k)][2], src[2 * (k)][3], src[2 * (k) + 1][0], src[2 * (k) + 1][1], src[2 * (k) + 1][2], src[2 * (k) + 1][3]}
#define P2_PV(src, g) do { if ((g) & 1) { O[(g) >> 1] = MFMA32(P2_VFR(src, 0), pb2, O[(g) >> 1]); O[(g) >> 1] = MFMA32(P2_VFR(src, 1), pb3, O[(g) >> 1]); } \
                           else { O[(g) >> 1] = MFMA32(P2_VFR(src, 0), pb0, O[(g) >> 1]); O[(g) >> 1] = MFMA32(P2_VFR(src, 1), pb1, O[(g) >> 1]); } } while (0)
__device__ __forceinline__ void h2(lcp vbase, f32x16 (&O)[4], const bf16x8& pb0, const bf16x8& pb1, const bf16x8& pb2, const bf16x8& pb3) {
    s16x4 va[4], vb[4];
    P2_VLOAD(va, 0); __builtin_amdgcn_sched_barrier(0);
    P2_VLOAD(vb, 1); __builtin_amdgcn_sched_barrier(0); P2_PV(va, 0); __builtin_amdgcn_sched_barrier(0);
    P2_VLOAD(va, 2); __builtin_amdgcn_sched_barrier(0); P2_PV(vb, 1); __builtin_amdgcn_sched_barrier(0);
    P2_VLOAD(vb, 3); __builtin_amdgcn_sched_barrier(0); P2_PV(va, 2); __builtin_amdgcn_sched_barrier(0);
    P2_VLOAD(va, 4); __builtin_amdgcn_sched_barrier(0); P2_PV(vb, 3); __builtin_amdgcn_sched_barrier(0);
    P2_VLOAD(vb, 5); __builtin_amdgcn_sched_barrier(0); P2_PV(va, 4); __builtin_amdgcn_sched_barrier(0);
    P2_VLOAD(va, 6); __builtin_amdgcn_sched_barrier(0); P2_PV(vb, 5); __builtin_amdgcn_sched_barrier(0);
    P2_VLOAD(vb, 7); __builtin_amdgcn_sched_barrier(0); P2_PV(va, 6); __builtin_amdgcn_sched_barrier(0);
    P2_PV(vb, 7);
}

#define P2_DEC_ISSUE(n, j) do { const int n_ = (n); if ((n_ & 15) == 0) pgbase = (size_t)__builtin_amdgcn_readfirstlane(pgl[n_ >> 4]) * (PAGE * 512); \
        const size_t o_ = pgbase + (size_t)(wid + 8 * (n_ & 15)) * 512; const float* ck_ = CK + o_; const float* cv_ = CV + o_; \
        const unsigned d_ = (unsigned)__builtin_amdgcn_readfirstlane(dbuf + (j) * 4096); \
        glds16_nt<0>(ck_, dlane, d_); glds16_nt<1024>(ck_, dlane, d_ + 1024); glds16_nt<0>(cv_, dlane, d_ + 2048); glds16_nt<1024>(cv_, dlane, d_ + 3072); } while (0)
#define P2_DEC_READ(j, KA, KB, VA, VB) do { const __attribute__((address_space(3))) f32x4* p_ = (const __attribute__((address_space(3))) f32x4*)(dlds + (j) * 4096 + lane * 32); \
        KA = p_[0]; KB = p_[1]; VA = p_[128]; VB = p_[129]; } while (0)
#define P2_DEC_COMP(KA0, KB0, VA0, VB0, KA1, KB1, VA1, VB1) do { const f32x4 qa = qlds[0], qb = qlds[1]; \
        float s0_ = qa.x * KA0.x + qa.y * KA0.y + qa.z * KA0.z + qa.w * KA0.w + qb.x * KB0.x + qb.y * KB0.y + qb.z * KB0.z + qb.w * KB0.w; \
        float s1_ = qa.x * KA1.x + qa.y * KA1.y + qa.z * KA1.z + qa.w * KA1.w + qb.x * KB1.x + qb.y * KB1.y + qb.z * KB1.z + qb.w * KB1.w; \
        s0_ += dppf<DPP_X1>(s0_); s1_ += dppf<DPP_X1>(s1_); s0_ += dppf<DPP_X2>(s0_); s1_ += dppf<DPP_X2>(s1_); s0_ += dppf<DPP_HM>(s0_); s1_ += dppf<DPP_HM>(s1_); \
        const float mn_ = fmaxf(dm, fmaxf(s0_, s1_)), f_ = __builtin_amdgcn_exp2f(dm - mn_), fo_ = dppf<DPP_R8>(f_); dm = mn_; \
        const float pa_ = __builtin_amdgcn_exp2f(s0_ - mn_), pb_ = __builtin_amdgcn_exp2f(s1_ - mn_), qa_ = dppf<DPP_R8>(pa_), qb_ = dppf<DPP_R8>(pb_); dl = dl * f_ + pa_ + pb_; \
        oa[0] = oa[0] * f_ + pa_ * VA0.x + pb_ * VA1.x; oa[1] = oa[1] * f_ + pa_ * VA0.y + pb_ * VA1.y; oa[2] = oa[2] * f_ + pa_ * VA0.z + pb_ * VA1.z; oa[3] = oa[3] * f_ + pa_ * VA0.w + pb_ * VA1.w; \
        oa[4] = oa[4] * f_ + pa_ * VB0.x + pb_ * VB1.x; oa[5] = oa[5] * f_ + pa_ * VB0.y + pb_ * VB1.y; oa[6] = oa[6] * f_ + pa_ * VB0.z + pb_ * VB1.z; oa[7] = oa[7] * f_ + pa_ * VB0.w + pb_ * VB1.w; \
        ob[0] = ob[0] * fo_ + qa_ * VA0.x + qb_ * VA1.x; ob[1] = ob[1] * fo_ + qa_ * VA0.y + qb_ * VA1.y; ob[2] = ob[2] * fo_ + qa_ * VA0.z + qb_ * VA1.z; ob[3] = ob[3] * fo_ + qa_ * VA0.w + qb_ * VA1.w; \
        ob[4] = ob[4] * fo_ + qa_ * VB0.x + qb_ * VB1.x; ob[5] = ob[5] * fo_ + qa_ * VB0.y + qb_ * VB1.y; ob[6] = ob[6] * fo_ + qa_ * VB0.z + qb_ * VB1.z; ob[7] = ob[7] * fo_ + qa_ * VB0.w + qb_ * VB1.w; } while (0)

__device__ __forceinline__ void run(const u16* DQ, const u16* DK, const u16* DV, const u16* GATE, const float* g_diff, float lam, float shift, u16* U,
                                    const float* CK, const float* CV, const int* PT, const float* dec, float* part, char* lds, int vcu, int du) {
    int tid = threadIdx.x; asm volatile("" : "+v"(tid));
    const int lane = tid & 63, r32 = lane & 31, hi = lane >> 5; const int wid = __builtin_amdgcn_readfirstlane(tid >> 6), c = wid >> 2, wq = wid & 3;
    const unsigned lds0 = (unsigned)(uintptr_t)lds; const lcp lds3 = (lcp)lds;
    const bool has_dec = du < DB * NSPLIT; const int db = has_dec ? du >> 3 : 0, dsp = du & 7;
    typedef __attribute__((address_space(3))) f32x4* lq_t; const lq_t qlds = (lq_t)(lds3 + 133120 + lane * 32);
    { const float* qsrc = dec + D_QS + db * 512 + lane * 8; qlds[0] = *(const f32x4*)qsrc; qlds[1] = *(const f32x4*)(qsrc + 4); }
    const __attribute__((address_space(3))) int* pgl = (const __attribute__((address_space(3))) int*)(lds3 + 133120 + 2048);
    if (lane < 8) ((__attribute__((address_space(3))) int*)(lds3 + 133120 + 2048))[lane] = has_dec ? PT[db * NPAGES + dsp * 8 + lane] : 0;
    asm volatile("s_waitcnt vmcnt(0) lgkmcnt(0)" ::: "memory");
    float dm = -1e30f, dl = 0.f, oa[8], ob[8];
#pragma unroll
    for (int i = 0; i < 8; ++i) { oa[i] = 0.f; ob[i] = 0.f; }
    const unsigned dbuf = lds0 + L_DEC + wid * 8192; const lcp dlds = lds3 + L_DEC + wid * 8192;
    const unsigned dlane = lane * 16; size_t pgbase = 0; int dn = 0;
    if (has_dec) { P2_DEC_ISSUE(0, 0); P2_DEC_ISSUE(1, 1); dn = 2; }
    const int bh = vcu >> 4, b = bh >> 2, h = bh & 3, xx = vcu & 15;
    const lcp kfr = lds3 + (c ? K1OFF : 0) + hi * 1024 + r32 * 16;
    const lcp vfr = lds3 + VOFF + ((lane >> 4) & 1) * 32 + (lane & 3) * 8 + (4 * hi + ((lane & 15) >> 2)) * 64;
    const unsigned klane = (unsigned)(lane * 512 + wid * 8) * 2u, vlane = (unsigned)((16 * (wid & 3) + (lane >> 2)) * 512 + (wid >> 2) * 32 + (lane & 3) * 8) * 2u;
    for (int ui = 0; ui < 2; ++ui) {
        const int x = ui == 0 ? 31 - xx : xx, NT = 2 * x + 2; const size_t rowb = (size_t)b * SEQ; const int q0 = 128 * x + 32 * wq;
        const int tstart = (4 * xx) % NT;
#define P2_TAU(t) (((t) + tstart) >= NT ? ((t) + tstart - NT) : ((t) + tstart))
        const u16* kt0 = DK + rowb * 512 + (2 * h) * 64; const u16* vt0 = DV + rowb * 512 + h * 128;
#define P2_K_ISSUE(t) do { const u16* kb__ = kt0 + (size_t)P2_TAU(t) * 64 * 512; const unsigned s_ = (unsigned)__builtin_amdgcn_readfirstlane(lds0 + ((t) & 1) * KBUF + wid * 1024); \
            glds16<0>(kb__, klane, s_); glds16<128>(kb__, klane, s_ + K1OFF); } while (0)
#define P2_V_ISSUE(t) do { const u16* vb__ = vt0 + (size_t)P2_TAU(t) * 64 * 512; const unsigned s_ = (unsigned)__builtin_amdgcn_readfirstlane(lds0 + VOFF + ((t) & 1) * VBUF + wid * 1024); \
            glds16<0>(vb__, vlane, s_); glds16<128>(vb__, vlane, s_ + 8192); } while (0)
        P2_K_ISSUE(0); P2_V_ISSUE(0);
        bf16x8 qf[4]; { const u16* qp = DQ + (rowb + q0 + r32) * 512 + (2 * h + c) * 64 + 8 * hi;
#pragma unroll
            for (int d0 = 0; d0 < 4; ++d0) qf[d0] = *(const bf16x8*)(qp + 16 * d0); }
        asm volatile("" : "+v"(qf[0]), "+v"(qf[1]), "+v"(qf[2]), "+v"(qf[3]));
        f32x16 O[4]; O[0] = f32x16{}; O[1] = f32x16{}; O[2] = f32x16{}; O[3] = f32x16{}; float lsum = 0.f;
        bf16x8 pb0 = {}, pb1 = {}, pb2 = {}, pb3 = {};
        int allow = 0;
        for (int hs = 0; hs <= 2 * NT; ++hs) {
            P2_WAIT_BAR(allow);
            allow = 0;
            if (!(hs & 1)) { const int tn = (hs >> 1) + 1; if (tn < NT) { P2_K_ISSUE(tn); allow = 2; } }
            else { const int tn = (hs + 1) >> 1; if (tn < NT) { P2_V_ISSUE(tn); allow = 2; } }
            if ((hs & 1) == c) {
                const int t = (hs - c) >> 1;
                const int tau = P2_TAU(t);
                if (t < NT && !(tau == NT - 1 && wq < 2)) { const lcp kb_ = kfr + (t & 1) * KBUF; const int qrel = q0 + r32 - 64 * tau;
                    if (tau < NT - 2) h1<false>(kb_, qf, lsum, shift, qrel, hi, pb0, pb1, pb2, pb3); else h1<true>(kb_, qf, lsum, shift, qrel, hi, pb0, pb1, pb2, pb3); }
            } else {
                if (has_dec && (dn - 2) < 128) {
                    f32x4 ka0, kb0, va0, vb0, ka1, kb1, va1, vb1;
                    P2_DEC_READ(0, ka0, kb0, va0, vb0); P2_DEC_READ(1, ka1, kb1, va1, vb1); asm volatile("s_waitcnt lgkmcnt(0)" ::: "memory");
                    if (dn < 128) { P2_DEC_ISSUE(dn, 0); P2_DEC_ISSUE(dn + 1, 1); allow += 8; } dn += 2;
                    P2_DEC_COMP(ka0, kb0, va0, vb0, ka1, kb1, va1, vb1); }
                __builtin_amdgcn_sched_barrier(0);
                const int t = (hs - 1 - c) >> 1;
                if (hs - 1 - c >= 0 && t < NT && !(P2_TAU(t) == NT - 1 && wq < 2)) h2(vfr + (t & 1) * VBUF, O, pb0, pb1, pb2, pb3);
            }
        }
        lsum += __shfl_xor(lsum, 32); const float inv = 1.0f / lsum;
#pragma unroll
        for (int eb = 0; eb < 4; ++eb)
#pragma unroll
            for (int r = 0; r < 16; ++r) O[eb][r] *= inv;
        asm volatile("s_waitcnt lgkmcnt(0)\n\ts_barrier" ::: "memory");
        __attribute__((address_space(3))) f32x4* ex = (__attribute__((address_space(3))) f32x4*)(lds3) + (wq * 16) * 64 + lane;
        if (c == 1) {
#pragma unroll
            for (int eb = 0; eb < 4; ++eb)
#pragma unroll
                for (int g4 = 0; g4 < 4; ++g4) ex[(eb * 4 + g4) * 64] = (f32x4){O[eb][4 * g4], O[eb][4 * g4 + 1], O[eb][4 * g4 + 2], O[eb][4 * g4 + 3]}; }
        asm volatile("s_waitcnt lgkmcnt(0)\n\ts_barrier" ::: "memory");
        if (c == 0) { float ss = 0.f;
#pragma unroll
            for (int eb = 0; eb < 4; ++eb) {
#pragma unroll
                for (int g4 = 0; g4 < 4; ++g4) { const f32x4 o1 = ex[(eb * 4 + g4) * 64];
#pragma unroll
                    for (int i = 0; i < 4; ++i) { const float o = O[eb][4 * g4 + i] - lam * o1[i]; O[eb][4 * g4 + i] = o; ss += o * o; } }
                __builtin_amdgcn_sched_barrier(0); }
            ss += __shfl_xor(ss, 32);
            const float rs = rsqrtf(ss * (1.f / 128.f) + EPS) * (1.f - LAM_INIT); const size_t row = rowb + q0 + r32;
#pragma unroll
            for (int eb = 0; eb < 4; ++eb)
#pragma unroll
                for (int g4 = 0; g4 < 4; ++g4) { const int e = eb * 32 + 8 * g4 + 4 * hi; const size_t o = row * 1024 + 512 + h * 128 + e;
                    const uint2 gt = *(const uint2*)(GATE + o); const f32x4 gr = *(const f32x4*)(g_diff + e);
                    uint2 w; w.x = pk2(O[eb][4 * g4] * rs * gr[0] * bf2f((u16)(gt.x & 0xffff)), O[eb][4 * g4 + 1] * rs * gr[1] * bf2f((u16)(gt.x >> 16)));
                    w.y = pk2(O[eb][4 * g4 + 2] * rs * gr[2] * bf2f((u16)(gt.y & 0xffff)), O[eb][4 * g4 + 3] * rs * gr[3] * bf2f((u16)(gt.y >> 16)));
                    *(uint2*)(U + o) = w; if (g4 == 3) __builtin_amdgcn_sched_barrier(0); } }
        asm volatile("s_waitcnt lgkmcnt(0)\n\ts_barrier" ::: "memory");
#undef P2_K_ISSUE
#undef P2_V_ISSUE
#undef P2_TAU
    }
    if (has_dec) {
        while (dn - 2 < 128) { asm volatile("s_waitcnt vmcnt(0)" ::: "memory"); f32x4 ka0, kb0, va0, vb0, ka1, kb1, va1, vb1;
            P2_DEC_READ(0, ka0, kb0, va0, vb0); P2_DEC_READ(1, ka1, kb1, va1, vb1); asm volatile("s_waitcnt lgkmcnt(0)" ::: "memory");
            if (dn < 128) { P2_DEC_ISSUE(dn, 0); P2_DEC_ISSUE(dn + 1, 1); } dn += 2;
            P2_DEC_COMP(ka0, kb0, va0, vb0, ka1, kb1, va1, vb1); }
        __syncthreads();
        __attribute__((address_space(3))) float* sm = (__attribute__((address_space(3))) float*)lds3;
        { const int hh = lane >> 4, co = (lane >> 3) & 1, e0 = 8 * (lane & 15);
#pragma unroll
          for (int i = 0; i < 8; ++i) { sm[(wid * 8 + hh * 2 + co) * PSTR + 2 + e0 + i] = oa[i]; sm[(wid * 8 + hh * 2 + (co ^ 1)) * PSTR + 2 + e0 + i] = ob[i]; }
          if ((lane & 7) == 0) { sm[(wid * 8 + (lane >> 3)) * PSTR] = dm; sm[(wid * 8 + (lane >> 3)) * PSTR + 1] = dl; } }
        __syncthreads();
        for (int idx = tid; idx < 8 * 128; idx += 512) { const int hc = idx >> 7, e = idx & 127; float mx = -1e30f;
            for (int w = 0; w < 8; ++w) mx = fmaxf(mx, sm[(w * 8 + hc) * PSTR]);
            float Ls = 0.f, Os = 0.f;
            for (int w = 0; w < 8; ++w) { const float f = exp2f(sm[(w * 8 + hc) * PSTR] - mx); Ls += sm[(w * 8 + hc) * PSTR + 1] * f; Os += sm[(w * 8 + hc) * PSTR + 2 + e] * f; }
            float* pp = part + ((size_t)(db * NSPLIT + dsp) * 8 + hc) * PSTR; pp[2 + e] = Os; if (e == 0) { pp[0] = mx; pp[1] = Ls; } }
        __syncthreads();
    }
}
#undef P2_WAIT_BAR
}

struct Args { const void* in[17]; float* out; unsigned char* ws; int ph_lo, ph_hi, mask, pad; };
__global__ void __launch_bounds__(NTHR, 2) mega(Args args) {
    extern __shared__ __attribute__((aligned(16))) unsigned char lds[];
    LAS unsigned char* L = (LAS unsigned char*)lds;
    volatile LAS unsigned* MISC = (volatile LAS unsigned*)(L + MISC_OFF);
    const int tid = threadIdx.x, lane = tid & 63, wave = __builtin_amdgcn_readfirstlane(tid >> 6), G = gridDim.x, bx = blockIdx.x;
    const int vcu = (G % 8 == 0) ? (bx % 8) * (G / 8) + bx / 8 : bx;
    const int mask = args.mask, lo = args.ph_lo, hi = args.ph_hi;
    unsigned char* ws = args.ws; float* out = args.out;
    const float* x = (const float*)args.in[0]; const float* xs = (const float*)args.in[1]; const float* CK = (const float*)args.in[2]; const float* CV = (const float*)args.in[3];
    const float* Sret = (const float*)args.in[4]; const int* PT = (const int*)args.in[5]; const float* ng = (const float*)args.in[6]; const float* w_in = (const float*)args.in[7]; const float* w_out = (const float*)args.in[8];
    const float* gq = (const float*)args.in[9]; const float* gk = (const float*)args.in[10]; const float* g_ret = (const float*)args.in[11]; const float* g_diff = (const float*)args.in[12];
    const float* lq1 = (const float*)args.in[13]; const float* lk1 = (const float*)args.in[14]; const float* lq2 = (const float*)args.in[15]; const float* lk2 = (const float*)args.in[16];
    u16 *WT1 = (u16*)(ws + WS_WT1), *WT2 = (u16*)(ws + WS_WT2), *XN = (u16*)(ws + WS_XN), *RQ = (u16*)(ws + WS_RQ), *RK = (u16*)(ws + WS_RK), *KTD = (u16*)(ws + WS_KTD), *VT = (u16*)(ws + WS_VT),
        *GATE = (u16*)(ws + WS_GATE), *DQ = (u16*)(ws + WS_DQ), *DK = (u16*)(ws + WS_DK), *DV = (u16*)(ws + WS_DV), *AO = (u16*)(ws + WS_AO), *ST = (u16*)(ws + WS_ST), *U = (u16*)(ws + WS_U);
    float* RA = (float*)(ws + WS_RA); float* dec = (float*)(ws + WS_DEC); unsigned* ctl = (unsigned*)(ws + WS_CTL);
    for (int u = tid; u < (LDS_BYTES - LDSCTL_OFF) / 4; u += NTHR) ((LAS unsigned*)(L + LDSCTL_OFF))[u] = 0u;
    __syncthreads();
    XcdBarrier bar = xcd_barrier_post(ctl + CW_BAR, MISC + 8);
#define IN(k) (lo <= (k) && (k) < hi)
#define BOTH(k) (IN(k) && IN((k) + 1))
    const int gw = vcu * NWAVES + wave, NGW = G * NWAVES;

#define DO_P0 do { \
        if (mask & F_DEC) { dec_proj_in(xs, ng, w_in, dec + D_ZS4, (LAS float*)(L + RING_OFF), bx, x, XN, gw, NGW); }     \
        LAS float* scr = (LAS float*)(L + RING_OFF + wave * 16384); \
        constexpr int I1 = (DM / 64) * (NZ / 32), I2 = (DM / 64) * (DM / 32); \
        for (int it = gw; it < I1 + I2; it += NGW) { if (it < I1) p0_transpose_item<true>(w_in, DM, NZ, WT1, scr, it, lane); else p0_transpose_item<false>(w_out, DM, DM, WT2, scr, it - I1, lane); } \
        if (!(mask & F_DEC)) { for (int m = gw; m < M; m += NGW) xn_row(x + (size_t)m * DM, ng, XN + (size_t)m * DM, lane); } } while (0)
    if (IN(0)) {
        DO_P0;
        if (BOTH(0)) xcd_barrier(bar);
    }
    if (IN(1)) {
#define DO_P1 do { pg8::Gemm g{XN, WT1, M, NZ, DM}; pg8::StaticOrder S; S.init(M, NZ, G, bx); \
            pg8::EpiProj E{RQ, RK, KTD, VT, GATE, DQ, DK, DV, out + O_KP, out + O_VP, gq, gk}; \
            pg8::gemm_phase<pg8::EpiProj, pg8::StaticOrder, true, true>(L + RING_OFF, g, S, E); } while (0)
        if (mask & F_PROJ) { DO_P1; }
        if (mask & F_DEC) { for (int b = bx; b < DB; b += G) dec_epi(b, dec + D_ZS4, gq, gk, dec, out + O_KS, out + O_VS); }
        if (BOTH(1)) xcd_barrier(bar);
    }
    if (IN(2)) {
#define DO_P2R do { for (int ti = bx; ti < 512; ti += 2 * G) ret_r1x2(VT, KTD, RA, ti, ti + G < 512 ? ti + G : -1, L + RING_OFF, wave, lane); } while (0)
        DO_P2R;
        { const float mq = wave_max(fabsf(gq[lane])), mk = wave_max(fabsf(gk[lane])); const float bnd = fmaxf(8.f * LOG2E * mq * mk - 60.f, 0.f);
          const float a_ = wave_sum(lq1[lane] * lk1[lane]), c_ = wave_sum(lq2[lane] * lk2[lane]); const float lam2 = __expf(a_) - __expf(c_) + LAM_INIT;
          p2f::run(DQ, DK, DV, GATE, g_diff, lam2, bnd, U, CK, CV, PT, dec, dec + D_PART, (char*)lds + RING_OFF, vcu, vcu); }
        if (BOTH(2)) xcd_barrier(bar);
    }
    float lam = 0.f;
    if (IN(3) || IN(4)) { const float a = wave_sum(lq1[lane] * lk1[lane]), c = wave_sum(lq2[lane] * lk2[lane]); lam = __expf(a) - __expf(c) + LAM_INIT; }
    if (IN(3)) {
        if (mask & F_RET) {
            for (int idx = bx * NTHR + tid; idx < 16 * 16384; idx += G * NTHR) { const int bh = idx >> 14, ed = idx & 16383; const float g128 = exp2f(128.f * log2_gamma(bh & 3));
                const float* ra = RA + ((size_t)bh * 32 << 14) + ed; u16* st = ST + ((size_t)bh * 32 << 14) + ed; float S = 0.f;
                float av[32];
#pragma unroll
                for (int c = 0; c < 32; ++c) av[c] = ra[(size_t)c << 14];
#pragma unroll
                for (int c = 0; c < 32; ++c) { st[(size_t)c << 14] = f2bf(S); S = g128 * S + av[c]; }
                out[O_RP + (size_t)bh * 16384 + (ed & 127) * 128 + (ed >> 7)] = S; }
        }
        if (mask & F_DEC) { for (int u = (bx + G / 2) % G; u < DB * 4; u += G) dec_ret(u, Sret, dec, g_ret, out + O_RS, dec + D_US, (LAS float*)(L + RING_OFF));
            for (int u = bx; u < DB * 4; u += G) dec_comb(u, dec + D_PART, dec, out + O_KS, out + O_VS, g_diff, lam, dec + D_US, (LAS float*)(L + RING_OFF)); }
        if (BOTH(3)) xcd_barrier(bar);
    }
    if (IN(4)) {
#define DO_P4 do { for (int ti = bx; ti < 512; ti += G) ret_r3(RQ, RK, VT, ST, GATE, g_ret, U, ti, L + RING_OFF, wave, lane); } while (0)
        DO_P4;
        if (mask & F_DEC) { __syncthreads(); dec_proj<false, true, true>(dec + D_US, nullptr, w_out, DM, out + O_YS, xs, (LAS float*)(L + RING_OFF), bx, G, WT2); }
        if (BOTH(4)) xcd_barrier(bar);
    }
    if (IN(5)) {
#define DO_P5 do { pg8::Gemm g{U, WT2, M, DM, DM}; pg8::StaticOrder S; S.init(M, DM, G, bx); pg8::EpiRes E{x, out + O_YP}; \
            pg8::gemm_phase<pg8::EpiRes, pg8::StaticOrder, true, true>(L + RING_OFF, g, S, E); } while (0)
        if (mask & F_OUT) { DO_P5; }

    }
#undef IN
#undef BOTH
}
#ifndef MK_N_LAUNCHES
#define MK_N_LAUNCHES 1
#endif
#ifndef MK_MASK
#define MK_MASK F_ALL
#endif
extern "C" void kernel_launch(void* const* d_in, const int* in_sizes, int n_in, void* d_out, int out_size, void* d_ws, size_t ws_size, hipStream_t stream) {
    static int grid = 0;
    if (grid == 0) {
        if (n_in != 17 || (size_t)out_size != O_END || ws_size < WS_END) { fprintf(stderr, "kernel_launch: unexpected sizes n_in %d out %d ws %zu\n", n_in, out_size, ws_size); grid = -1; return; }
        int dev = 0, cus = 0, per_cu = 0;
        if (hipGetDevice(&dev) != hipSuccess || hipDeviceGetAttribute(&cus, hipDeviceAttributeMultiprocessorCount, dev) != hipSuccess) { grid = -1; return; }
        if (hipFuncSetAttribute((const void*)mega, hipFuncAttributeMaxDynamicSharedMemorySize, LDS_BYTES) != hipSuccess) { fprintf(stderr, "kernel_launch: hipFuncSetAttribute failed\n"); grid = -1; return; }
        if (hipOccupancyMaxActiveBlocksPerMultiprocessor(&per_cu, (const void*)mega, NTHR, LDS_BYTES) != hipSuccess || per_cu < 1) { fprintf(stderr, "kernel_launch: occupancy query says %d\n", per_cu); }
        (void)hipGetLastError();
        grid = cus;
        if (grid != 256) { fprintf(stderr, "kernel_launch: this kernel's phase P2 is dealt for exactly 256 CUs (got %d)\n", grid); grid = -1; return; }
    }
    if (grid < 0) return;
    if (hipMemsetAsync((char*)d_ws + WS_CTL, 0, CTL_ZERO_BYTES, stream) != hipSuccess) return;
    Args a{};
    for (int i = 0; i < 17; ++i) a.in[i] = d_in[i];
    a.out = (float*)d_out; a.ws = (unsigned char*)d_ws; a.mask = MK_MASK; a.pad = 0;
#if MK_N_LAUNCHES == 1
    a.ph_lo = 0; a.ph_hi = 6;
    hipLaunchKernelGGL(mega, dim3(grid), dim3(NTHR), LDS_BYTES, stream, a);
#endif
}
```

```cpp
#define MK_N_LAUNCHES 1
#define MK_MASK 63
#include <hip/hip_runtime.h>
#include <cstdio>
#include <cstdint>

typedef unsigned short u16;
constexpr int DM = 1024, NB = 4, SEQ = 4096, M = NB * SEQ, DB = 32, PAST = 8192, PAGE = 128, NPAGES = 64;
constexpr int NZ = 4096;
constexpr float EPS = 1e-6f;
constexpr float LOG2E = 1.4426950408889634f;
constexpr float C2 = 0.125f * LOG2E;
constexpr float LAM_INIT = 0.2f;
constexpr size_t O_YP = 0, O_YS = O_YP + (size_t)M * DM, O_KP = O_YS + (size_t)DB * DM, O_VP = O_KP + (size_t)M * 512, O_RP = O_VP + (size_t)M * 512,
                 O_KS = O_RP + (size_t)NB * 4 * 128 * 128, O_VS = O_KS + (size_t)DB * 512, O_RS = O_VS + (size_t)DB * 512, O_END = O_RS + (size_t)DB * 4 * 128 * 128;
constexpr size_t MiB = 1u << 20;
constexpr size_t WS_CTL = 0, WS_WT1 = 2 * MiB, WS_WT2 = 10 * MiB, WS_XN = 16 * MiB, WS_RQ = 48 * MiB, WS_RK = 64 * MiB, WS_KTD = 80 * MiB, WS_VT = 96 * MiB,
                 WS_GATE = 112 * MiB, WS_DQ = 144 * MiB, WS_DK = 160 * MiB, WS_DV = 176 * MiB, WS_AO = 192 * MiB, WS_RA = 224 * MiB, WS_ST = 256 * MiB, WS_U = 272 * MiB,
                 WS_DEC = 304 * MiB, WS_Z = 320 * MiB, WS_END = WS_Z + (size_t)M * NZ * 4;
constexpr size_t D_ZS = 0, D_QS = D_ZS + 32 * 4096, D_RQS = D_QS + 32 * 512, D_RKS = D_RQS + 32 * 512, D_RVS = D_RKS + 32 * 512, D_GS = D_RVS + 32 * 512, D_US = D_GS + 32 * 1024,
                 D_PART = D_US + 32 * 1024;
constexpr size_t D_ZS4 = (size_t)1 << 20;
constexpr int NSPLIT = 8, PSTR = 130;

__device__ __forceinline__ float bf2f(u16 v) { return __uint_as_float((unsigned)v << 16); }
__device__ __forceinline__ u16 f2bf(float f) { unsigned u = __float_as_uint(f); return (u16)((u + 0x7fffu + ((u >> 16) & 1u)) >> 16); }
__device__ __forceinline__ float silu(float x) { return x / (1.f + __expf(-x)); }
__device__ __forceinline__ float wave_sum(float v) {
#pragma unroll
    for (int o = 1; o < 64; o <<= 1) v += __shfl_xor(v, o);
    return v;
}
__device__ __forceinline__ float wave_max(float v) {
#pragma unroll
    for (int o = 1; o < 64; o <<= 1) v = fmaxf(v, __shfl_xor(v, o));
    return v;
}
__device__ __forceinline__ float log2_gamma(int h) { return __log2f(1.0f - exp2f(-5.0f - (float)h)); }
__device__ __forceinline__ size_t tile_idx(int b, int h, int c) { return ((size_t)(b * 4 + h) * 32 + c); }
__device__ __forceinline__ void sincos_rev(float ang, float& s, float& c) {
    float x = ang * 0.15915494309189535f; x = x - floorf(x);
    s = __builtin_amdgcn_sinf(x); c = __builtin_amdgcn_cosf(x);
}

#define GAS __attribute__((address_space(1)))
#define LAS __attribute__((address_space(3)))
namespace pg8 {
#define PG8_LAS __attribute__((address_space(3)))
typedef unsigned short bf16_t;
typedef short bf16x8 __attribute__((ext_vector_type(8)));
typedef float f32x4 __attribute__((ext_vector_type(4)));
typedef unsigned u32x4 __attribute__((ext_vector_type(4)));
constexpr int BM = 256, BK = 64, HALF = 128, HTB = HALF * BK * 2  , STAGE_BYTES = 8 * HTB, NXCD = 8, WGM = 8;

__host__ __device__ __forceinline__ int lds_byte(int r, int c) { const int st = (r >> 4) * 2 + (c >> 5), rr = r & 15, cc = c & 31, ob = rr * 64 + cc * 2; return st * 1024 + (ob ^ (((ob >> 9) & 1) << 5)); }
__host__ __device__ __forceinline__ void stage_rc(int b, int& R, int& C) { const int st = b / 1024, sb = b % 1024, swz = sb ^ (((sb >> 9) & 1) << 5); R = (st >> 1) * 16 + swz / 64; C = (st & 1) * 32 + (swz % 64) / 2; }
__host__ __device__ __forceinline__ int perm32(int rho) { const int n = rho >> 4, i = rho & 15; return 8 * (i >> 2) + 4 * n + (i & 3); }

struct Unit { int pm, pn; };
struct Gemm { const bf16_t* A; const bf16_t* Bt; int M, N, K; };

struct StaticOrder {
    int nM, nN, nwg, G, c;
    __host__ __device__ void init(int M, int N, int G_, int c_) { nM = M / BM; nN = N / BM; nwg = nM * nN; G = G_; c = c_; }
    __host__ __device__ bool next(int i, Unit& u) const {
        const long L = (long)i * G + c; if (L >= nwg) return false;
        int wgid = (int)L; { const int q = nwg / NXCD, r = nwg % NXCD, xcd = wgid % NXCD, off = wgid / NXCD; wgid = (xcd < r ? xcd * (q + 1) : r * (q + 1) + (xcd - r) * q) + off; }
        const int nig = WGM * nN, gid = wgid / nig, fm = gid * WGM, gsz = (nM - fm) < WGM ? (nM - fm) : WGM;
        u.pm = fm + ((wgid % nig) % gsz); u.pn = (wgid % nig) / gsz; return true;
    }
    __device__ __forceinline__ void a_ready(const Unit&) const {}
    __device__ __forceinline__ void done(const Unit&) const {}
};

__device__ __forceinline__ unsigned cvt_pk_bf16(float lo, float hi) { unsigned r; asm volatile("v_cvt_pk_bf16_f32 %0, %1, %2" : "=v"(r) : "v"(lo), "v"(hi)); return r; }
__device__ __forceinline__ unsigned pk_bf16(float lo, float hi) { return cvt_pk_bf16(lo, hi); }
__device__ __forceinline__ float silu_fast(float x) { return x * __builtin_amdgcn_rcpf(1.f + __builtin_amdgcn_exp2f(-1.4426950408889634f * x)); }
struct EpiProj {
    static constexpr bool PERM = true, AFTER_DRAIN = false, APERM = true;
    u16 *RQ, *RK, *KTD, *VT, *GATE, *DQ, *DK, *DV; float *outK, *outV; const float *gq, *gk;
    __device__ __forceinline__ void operator()(const f32x4 (&acc)[2][2][4][2], const Unit& u, int wr, int wc, int fr, int fq) const {
        const int sec = u.pn >> 1, half = u.pn & 1;
        const int rbase = u.pm * BM + wr * 64 + 4 * fr, b = (u.pm * BM) / SEQ, pbase = (u.pm * BM) % SEQ + wr * 64 + 4 * fr;
        if (sec <= 1) {
            const int head = 2 * half + (wc >> 1), i0 = 32 * (wc & 1) + 8 * fq;
            float frq[8];
#pragma unroll
            for (int j = 0; j < 8; ++j) frq[j] = exp2f(-(float)(i0 + j) * (13.287712379549449f / 64.f));
            const float lg = log2_gamma(head); u16* dst = sec == 0 ? RQ : RK; const float sc = sec == 0 ? 1.f : 0.08838834764831845f;
#pragma unroll
            for (int ai = 0; ai < 2; ++ai) {
                unsigned t1[8][2], t2[8][2]; float e1[8], e2[8];
#pragma unroll
                for (int m = 0; m < 4; ++m) { const int pos = pbase + ai * 128 + m; const size_t r = (size_t)(rbase + ai * 128 + m);
                    float o1[8], o2[8];
#pragma unroll
                    for (int j = 0; j < 8; ++j) { float s, c; sincos_rev((float)pos * frq[j], s, c); const float x1 = acc[ai][0][m][j >> 2][j & 3], x2 = acc[ai][1][m][j >> 2][j & 3];
                        o1[j] = (x1 * c - x2 * s) * sc; o2[j] = (x2 * c + x1 * s) * sc; }
                    u32x4 w1, w2; w1.x = pk_bf16(o1[0], o1[1]); w1.y = pk_bf16(o1[2], o1[3]); w1.z = pk_bf16(o1[4], o1[5]); w1.w = pk_bf16(o1[6], o1[7]);
                    w2.x = pk_bf16(o2[0], o2[1]); w2.y = pk_bf16(o2[2], o2[3]); w2.z = pk_bf16(o2[4], o2[5]); w2.w = pk_bf16(o2[6], o2[7]);
                    *(u32x4*)(dst + r * 512 + head * 128 + i0) = w1; *(u32x4*)(dst + r * 512 + head * 128 + 64 + i0) = w2;
                    if (sec == 1) { const float dec = __builtin_amdgcn_exp2f((float)(127 - (pos & 127)) * lg);
#pragma unroll
                        for (int j = 0; j < 8; ++j) { if (m & 1) { t1[j][m >> 1] = pk_bf16(e1[j], o1[j] * dec); t2[j][m >> 1] = pk_bf16(e2[j], o2[j] * dec); } else { e1[j] = o1[j] * dec; e2[j] = o2[j] * dec; } } } }
                if (sec == 1) { const int pos0 = pbase + ai * 128; u16* kt = KTD + tile_idx(b, head, pos0 >> 7) * 16384 + (pos0 & 127);
#pragma unroll
                    for (int j = 0; j < 8; ++j) { *(uint2*)(kt + (i0 + j) * 128) = make_uint2(t1[j][0], t1[j][1]); *(uint2*)(kt + (64 + i0 + j) * 128) = make_uint2(t2[j][0], t2[j][1]); } } }
        } else if (sec == 2) {
#pragma unroll
            for (int ai = 0; ai < 2; ++ai) { const int pos0 = pbase + ai * 128;
#pragma unroll
                for (int bj = 0; bj < 2; ++bj) { u16* vt = VT + tile_idx(b, 2 * half + bj, pos0 >> 7) * 16384 + (pos0 & 127);
#pragma unroll
                    for (int j = 0; j < 8; ++j) *(uint2*)(vt + (32 * wc + 8 * fq + j) * 128) =
                        make_uint2(pk_bf16(acc[ai][bj][0][j >> 2][j & 3], acc[ai][bj][1][j >> 2][j & 3]), pk_bf16(acc[ai][bj][2][j >> 2][j & 3], acc[ai][bj][3][j >> 2][j & 3])); } }
        } else if (sec == 3 || sec == 7) {
            const int cb = (sec == 3 ? 0 : 512) + 256 * half + 32 * wc + 8 * fq;
#pragma unroll
            for (int ai = 0; ai < 2; ++ai)
#pragma unroll
                for (int m = 0; m < 4; ++m) { const size_t r = (size_t)(rbase + ai * 128 + m);
#pragma unroll
                    for (int bj = 0; bj < 2; ++bj) { const f32x4 v0 = acc[ai][bj][m][0], v1 = acc[ai][bj][m][1]; u32x4 w;
                        w.x = pk_bf16(silu_fast(v0[0]), silu_fast(v0[1])); w.y = pk_bf16(silu_fast(v0[2]), silu_fast(v0[3])); w.z = pk_bf16(silu_fast(v1[0]), silu_fast(v1[1])); w.w = pk_bf16(silu_fast(v1[2]), silu_fast(v1[3]));
                        *(u32x4*)(GATE + r * 1024 + cb + 128 * bj) = w; } }
        } else if (sec == 4 || sec == 5) {
            const int gi = 4 * half + wc; const float* g = sec == 4 ? gq : gk;
            float gv[2][8], frq[8];
#pragma unroll
            for (int j = 0; j < 8; ++j) { gv[0][j] = g[16 * fq + j]; gv[1][j] = g[16 * fq + 8 + j]; frq[j] = exp2f(-(float)j * (18.931568569324174f / 8.f)); }
#pragma unroll
            for (int ai = 0; ai < 2; ++ai)
#pragma unroll
                for (int m = 0; m < 4; ++m) { const int pos = pbase + ai * 128 + m; const size_t r = (size_t)(rbase + ai * 128 + m);
                    float y[2][8]; float ss = 0.f;
#pragma unroll
                    for (int bj = 0; bj < 2; ++bj)
#pragma unroll
                        for (int j = 0; j < 8; ++j) { y[bj][j] = acc[ai][bj][m][j >> 2][j & 3]; ss += y[bj][j] * y[bj][j]; }
                    ss += __shfl_xor(ss, 16); ss += __shfl_xor(ss, 32);
                    const float rs = rsqrtf(ss * (1.f / 64.f) + EPS);
#pragma unroll
                    for (int bj = 0; bj < 2; ++bj)
#pragma unroll
                        for (int j = 0; j < 8; ++j) y[bj][j] *= rs * gv[bj][j];
                    if (fq == 0) {
#pragma unroll
                        for (int j = 0; j < 8; ++j) { float s, c; sincos_rev((float)pos * frq[j], s, c); const float x1 = y[0][j], x2 = y[1][j]; y[0][j] = x1 * c - x2 * s; y[1][j] = x2 * c + x1 * s; } }
                    const size_t o = r * 512 + gi * 64 + 16 * fq;
                    if (sec == 4) { u32x4 w0, w1;
                        w0.x = pk_bf16(y[0][0] * C2, y[0][1] * C2); w0.y = pk_bf16(y[0][2] * C2, y[0][3] * C2); w0.z = pk_bf16(y[0][4] * C2, y[0][5] * C2); w0.w = pk_bf16(y[0][6] * C2, y[0][7] * C2);
                        w1.x = pk_bf16(y[1][0] * C2, y[1][1] * C2); w1.y = pk_bf16(y[1][2] * C2, y[1][3] * C2); w1.z = pk_bf16(y[1][4] * C2, y[1][5] * C2); w1.w = pk_bf16(y[1][6] * C2, y[1][7] * C2);
                        *(u32x4*)(DQ + o) = w0; *(u32x4*)(DQ + o + 8) = w1;
                    } else { u32x4 w0, w1;
                        w0.x = pk_bf16(y[0][0], y[0][1]); w0.y = pk_bf16(y[0][2], y[0][3]); w0.z = pk_bf16(y[0][4], y[0][5]); w0.w = pk_bf16(y[0][6], y[0][7]);
                        w1.x = pk_bf16(y[1][0], y[1][1]); w1.y = pk_bf16(y[1][2], y[1][3]); w1.z = pk_bf16(y[1][4], y[1][5]); w1.w = pk_bf16(y[1][6], y[1][7]);
                        *(u32x4*)(DK + o) = w0; *(u32x4*)(DK + o + 8) = w1;
                        *(f32x4*)(outK + o) = (f32x4){y[0][0], y[0][1], y[0][2], y[0][3]}; *(f32x4*)(outK + o + 4) = (f32x4){y[0][4], y[0][5], y[0][6], y[0][7]};
                        *(f32x4*)(outK + o + 8) = (f32x4){y[1][0], y[1][1], y[1][2], y[1][3]}; *(f32x4*)(outK + o + 12) = (f32x4){y[1][4], y[1][5], y[1][6], y[1][7]}; } }
        } else {
            const int cb = 256 * half + 32 * wc + 8 * fq;
#pragma unroll
            for (int ai = 0; ai < 2; ++ai)
#pragma unroll
                for (int m = 0; m < 4; ++m) { const size_t r = (size_t)(rbase + ai * 128 + m);
#pragma unroll
                    for (int bj = 0; bj < 2; ++bj) { const f32x4 v0 = acc[ai][bj][m][0], v1 = acc[ai][bj][m][1]; u32x4 w;
                        w.x = pk_bf16(v0[0], v0[1]); w.y = pk_bf16(v0[2], v0[3]); w.z = pk_bf16(v1[0], v1[1]); w.w = pk_bf16(v1[2], v1[3]);
                        const size_t o = r * 512 + cb + 128 * bj; *(u32x4*)(DV + o) = w; *(f32x4*)(outV + o) = v0; *(f32x4*)(outV + o + 4) = v1; } }
        }
    }
};
struct EpiRes {
    static constexpr bool PERM = true, AFTER_DRAIN = false, APERM = false;
    const float* base; float* out;
    __device__ __forceinline__ void operator()(const f32x4 (&acc)[2][2][4][2], const Unit& u, int wr, int wc, int fr, int fq) const {
        const int cb = u.pn * BM + 32 * wc + 8 * fq;
#pragma unroll
        for (int ai = 0; ai < 2; ++ai)
#pragma unroll
            for (int m = 0; m < 4; ++m) { const size_t r = (size_t)(u.pm * BM + wr * 64 + fr + ai * 128 + m * 16);
#pragma unroll
                for (int bj = 0; bj < 2; ++bj)
#pragma unroll
                    for (int n = 0; n < 2; ++n) { const size_t o = r * 1024 + cb + 128 * bj + 4 * n; *(f32x4*)(out + o) = *(const f32x4*)(base + o) + acc[ai][bj][m][n]; } }
    }
};
template <class Epi, class Sched, bool ALIGN_EPI = false, bool SP2 = false>
__device__ __forceinline__ void gemm_phase(PG8_LAS unsigned char* lds, const Gemm g, const Sched& S, const Epi& E) {
    const int tid = threadIdx.x, wid = __builtin_amdgcn_readfirstlane(tid >> 6), lane = tid & 63, wr = wid >> 2, wc = wid & 3, fr = lane & 15, fq = lane >> 4;
    const int K = g.K, nt = K / BK;
    unsigned voffA[2], voffB[2];
#pragma unroll
    for (int i = 0; i < 2; ++i) { int R, C; stage_rc(tid * 16 + i * 8192, R, C); const int Rb = Epi::PERM ? ((R & ~31) + perm32(R & 31)) : R;
        const int Ra = Epi::APERM ? ((R & 64) | ((R & 15) << 2) | ((R >> 4) & 3)) : R;
        voffA[i] = (unsigned)(Ra * K + C) * 2u; voffB[i] = (unsigned)(Rb * K + C) * 2u; }
    const size_t kstep = (size_t)(BK * 2);
    const size_t hstep = (size_t)HALF * K * 2;
    const size_t tstep = 2 * hstep;
    const unsigned ldsw = (unsigned)wid * 1024u;
    const int aoff = lds_byte(wr * 64 + fr, fq * 8), boff = lds_byte(wc * 32 + fr, fq * 8);
#define PG8_SA(b, h) (((b) * 2 + (h)) * HTB)
#define PG8_SB(b, h) ((4 + (b) * 2 + (h)) * HTB)
#define PG8_STAGE(bufoff, gbase, voff) do { _Pragma("unroll") for (int _i = 0; _i < 2; ++_i) \
        __builtin_amdgcn_global_load_lds((const unsigned*)((const char*)(gbase) + (voff)[_i]), (PG8_LAS unsigned*)(lds + (bufoff) + ldsw + _i * 8192), 16, 0, 0); } while (0)
#define PG8_LDA(dst, b, h) do { _Pragma("unroll") for (int m = 0; m < 4; ++m) _Pragma("unroll") for (int k = 0; k < 2; ++k) dst[m][k] = *(const PG8_LAS bf16x8*)(lds + PG8_SA(b, h) + aoff + m * 2048 + k * 1024); } while (0)
#define PG8_LDB(dst, b, h) do { _Pragma("unroll") for (int n = 0; n < 2; ++n) _Pragma("unroll") for (int k = 0; k < 2; ++k) dst[n][k] = *(const PG8_LAS bf16x8*)(lds + PG8_SB(b, h) + boff + n * 2048 + k * 1024); } while (0)
#define PG8_MMA(ai, bj, At, Bt) do { __builtin_amdgcn_s_setprio(1); _Pragma("unroll") for (int m = 0; m < 4; ++m) _Pragma("unroll") for (int n = 0; n < 2; ++n) _Pragma("unroll") for (int k = 0; k < 2; ++k) \
        acc[ai][bj][m][n] = __builtin_amdgcn_mfma_f32_16x16x32_bf16(Bt[n][k], At[m][k], acc[ai][bj][m][n], 0, 0, 0); __builtin_amdgcn_s_setprio(0); } while (0)
#define PG8_WAIT_V(n) asm volatile("s_waitcnt vmcnt(" #n ")" ::: "memory")
#define PG8_WAIT_L(n) asm volatile("s_waitcnt lgkmcnt(" #n ")" ::: "memory")
#define PG8_BAR __builtin_amdgcn_s_barrier()
#define PG8_SCHED __builtin_amdgcn_sched_barrier(0)
    Unit cur, nxt; int ui = 0;
    if (!S.next(0, cur)) return;
    f32x4 acc[2][2][4][2];
#pragma unroll
    for (int a = 0; a < 2; ++a)
#pragma unroll
        for (int b = 0; b < 2; ++b)
#pragma unroll
            for (int m = 0; m < 4; ++m)
#pragma unroll
                for (int n = 0; n < 2; ++n) acc[a][b][m][n] = (f32x4){0.f, 0.f, 0.f, 0.f};
    bf16x8 At[4][2], B0[2][2], B1[2][2];
    const char* cA = (const char*)g.A + (size_t)cur.pm * tstep; const char* cB = (const char*)g.Bt + (size_t)cur.pn * tstep;
    S.a_ready(cur);
    if constexpr (SP2) {
        PG8_STAGE(PG8_SB(0, 0), cB, voffB); PG8_STAGE(PG8_SB(0, 1), cB + hstep, voffB); PG8_STAGE(PG8_SA(0, 0), cA, voffA); PG8_STAGE(PG8_SA(0, 1), cA + hstep, voffA);
        if (wr == 1) PG8_BAR;
        PG8_WAIT_V(2); PG8_BAR;
        PG8_STAGE(PG8_SB(1, 0), cB + kstep, voffB); PG8_STAGE(PG8_SA(1, 0), cA + kstep, voffA); PG8_STAGE(PG8_SB(1, 1), cB + hstep + kstep, voffB);
        PG8_WAIT_V(6); PG8_BAR;
    } else {
        PG8_STAGE(PG8_SB(0, 0), cB, voffB); PG8_STAGE(PG8_SA(0, 0), cA, voffA); PG8_STAGE(PG8_SB(0, 1), cB + hstep, voffB); PG8_STAGE(PG8_SA(0, 1), cA + hstep, voffA);
        if (wr == 1) PG8_BAR;
        PG8_WAIT_V(4); PG8_BAR;
        PG8_STAGE(PG8_SB(1, 0), cB + kstep, voffB); PG8_STAGE(PG8_SA(1, 0), cA + kstep, voffA); PG8_STAGE(PG8_SB(1, 1), cB + hstep + kstep, voffB);
        PG8_WAIT_V(6); PG8_BAR;
    }
    for (;;) {
        const bool has_next = S.next(ui + 1, nxt);
        const char* nA = has_next ? (const char*)g.A + (size_t)nxt.pm * tstep : cA; const char* nB = has_next ? (const char*)g.Bt + (size_t)nxt.pn * tstep : cB;
        for (int t = 0; t < nt; t += 2) {
            const bool last = (t == nt - 2);
            const char* a1 = cA + (size_t)(t + 1) * kstep;
            const char* a2 = last ? nA : cA + (size_t)(t + 2) * kstep; const char* b2 = last ? nB : cB + (size_t)(t + 2) * kstep;
            const char* a3 = a2 + kstep; const char* b3 = b2 + kstep;
            if (last && has_next) S.a_ready(nxt);
            if constexpr (SP2) {
            PG8_LDB(B0, 0, 0); PG8_LDB(B1, 0, 1); PG8_SCHED; PG8_LDA(At, 0, 0); PG8_STAGE(PG8_SA(1, 1), a1 + hstep, voffA);
            PG8_WAIT_V(8); PG8_WAIT_L(0); PG8_BAR; PG8_MMA(0, 0, At, B0); PG8_MMA(0, 1, At, B1); PG8_BAR; PG8_SCHED;
            PG8_LDA(At, 0, 1); PG8_STAGE(PG8_SB(0, 0), b2, voffB); PG8_STAGE(PG8_SB(0, 1), b2 + hstep, voffB); PG8_STAGE(PG8_SA(0, 0), a2, voffA);
            PG8_WAIT_V(8); PG8_WAIT_L(0); PG8_BAR; PG8_MMA(1, 0, At, B0); PG8_MMA(1, 1, At, B1); PG8_BAR; PG8_SCHED;
            PG8_LDB(B0, 1, 0); PG8_LDB(B1, 1, 1); PG8_SCHED; PG8_LDA(At, 1, 0); PG8_STAGE(PG8_SA(0, 1), a2 + hstep, voffA);
            PG8_WAIT_V(8); PG8_WAIT_L(0); PG8_BAR; PG8_MMA(0, 0, At, B0); PG8_MMA(0, 1, At, B1); PG8_BAR; PG8_SCHED;
            PG8_LDA(At, 1, 1); PG8_STAGE(PG8_SB(1, 0), b3, voffB); PG8_STAGE(PG8_SB(1, 1), b3 + hstep, voffB); PG8_STAGE(PG8_SA(1, 0), a3, voffA);
            PG8_WAIT_V(8); PG8_WAIT_L(0); PG8_BAR; PG8_MMA(1, 0, At, B0); PG8_MMA(1, 1, At, B1); PG8_BAR; PG8_SCHED;
            } else {
            PG8_LDB(B0, 0, 0); PG8_SCHED; PG8_LDA(At, 0, 0); PG8_STAGE(PG8_SA(1, 1), a1 + hstep, voffA);
            PG8_WAIT_L(8); PG8_BAR; PG8_WAIT_L(0); PG8_MMA(0, 0, At, B0); PG8_BAR; PG8_SCHED;
            PG8_LDB(B1, 0, 1); PG8_STAGE(PG8_SB(0, 0), b2, voffB);
            PG8_BAR; PG8_WAIT_L(0); PG8_MMA(0, 1, At, B1); PG8_BAR;
            PG8_LDA(At, 0, 1); PG8_STAGE(PG8_SA(0, 0), a2, voffA);
            PG8_BAR; PG8_WAIT_L(0); PG8_MMA(1, 0, At, B0); PG8_BAR; PG8_SCHED;
            PG8_STAGE(PG8_SB(0, 1), b2 + hstep, voffB);
            PG8_WAIT_V(6); PG8_BAR; PG8_MMA(1, 1, At, B1); PG8_BAR;
            PG8_LDB(B0, 1, 0); PG8_SCHED; PG8_LDA(At, 1, 0); PG8_STAGE(PG8_SA(0, 1), a2 + hstep, voffA);
            PG8_WAIT_L(8); PG8_BAR; PG8_WAIT_L(0); PG8_MMA(0, 0, At, B0); PG8_BAR; PG8_SCHED;
            PG8_LDB(B1, 1, 1); PG8_STAGE(PG8_SB(1, 0), b3, voffB);
            PG8_BAR; PG8_WAIT_L(0); PG8_MMA(0, 1, At, B1); PG8_BAR;
            PG8_LDA(At, 1, 1); PG8_STAGE(PG8_SA(1, 0), a3, voffA);
            PG8_BAR; PG8_WAIT_L(0); PG8_MMA(1, 0, At, B0); PG8_BAR; PG8_SCHED;
            PG8_STAGE(PG8_SB(1, 1), b3 + hstep, voffB);
            PG8_WAIT_V(6); PG8_BAR; PG8_MMA(1, 1, At, B1); PG8_BAR;
            }
        }
        if constexpr (ALIGN_EPI) { if (wr == 0) PG8_BAR; }
        if constexpr (!Epi::AFTER_DRAIN) { E(acc, cur, wr, wc, fr, fq); S.done(cur); }
        if (!has_next) break;
#pragma unroll
        for (int a = 0; a < 2; ++a)
#pragma unroll
            for (int b = 0; b < 2; ++b)
#pragma unroll
                for (int m = 0; m < 4; ++m)
#pragma unroll
                    for (int n = 0; n < 2; ++n) acc[a][b][m][n] = (f32x4){0.f, 0.f, 0.f, 0.f};
        cur = nxt; cA = nA; cB = nB; ++ui;
        if constexpr (ALIGN_EPI) { if (wr == 1) PG8_BAR; }
    }
    PG8_WAIT_V(0);
    if constexpr (!ALIGN_EPI) { if (wr == 0) PG8_BAR; }
    PG8_BAR;
    if constexpr (Epi::AFTER_DRAIN) { E.fused(acc, cur, wr, wc, fr, fq, lds, wid, lane); S.done(cur); }
#undef PG8_SA
#undef PG8_SB
#undef PG8_STAGE
#undef PG8_LDA
#undef PG8_LDB
#undef PG8_MMA
#undef PG8_WAIT_V
#undef PG8_WAIT_L
#undef PG8_BAR
#undef PG8_SCHED
}
}

#define XB_TMO      128
#define XB_XCNT(j)  (256  + 64 * (j))
#define XB_XSUB(j)  (1280 + 64 * (j))
#define XB_XGEN(j)  (2304 + 64 * (j))
#define XB_TOP      3328
#define XB_TOPGEN   3392
#define XCD_BAR_WORDS 3456
#define XB_SPIN_CAP (1u << 18)

__device__ __forceinline__ unsigned xb_ld(unsigned* p)              { return __hip_atomic_load(p, __ATOMIC_RELAXED, __HIP_MEMORY_SCOPE_AGENT); }
__device__ __forceinline__ unsigned xb_add(unsigned* p, unsigned v) { return __hip_atomic_fetch_add(p, v, __ATOMIC_RELAXED, __HIP_MEMORY_SCOPE_AGENT); }
__device__ __forceinline__ unsigned xb_xcc_id() { return (unsigned)__builtin_amdgcn_s_getreg((3 << 11) | 20) & 0xFu; }
#define XB_SPIN(cond, bar) do { unsigned _sp = 0; while (cond) { __builtin_amdgcn_s_sleep(1); \
    if ((++_sp & 255u) == 0u) { if (xb_ld(&(bar)[XB_TMO])) break; if (_sp > XB_SPIN_CAP) { atomicAdd(&(bar)[XB_TMO], 1u); break; } } } } while (0)

struct XcdBarrier {
    unsigned* bar; unsigned x;
    volatile LAS unsigned* st;
};

__device__ __forceinline__ XcdBarrier xcd_barrier_post(unsigned* bar, volatile LAS unsigned* st) {
    XcdBarrier b; b.bar = bar; b.x = xb_xcc_id(); b.st = st;
    if (threadIdx.x == 0) (void)xb_add(&bar[XB_XCNT(b.x)], 1u);
    return b;
}
__device__ __forceinline__ void xcd_barrier_complete(unsigned* bar, unsigned x, unsigned& nloc, unsigned& nx) {
    const unsigned G = gridDim.x * gridDim.y * gridDim.z;
    unsigned sum, cnt, mine, sp = 0u;
    for (;;) {
        sum = 0u; cnt = 0u; mine = 0u;
#pragma unroll
        for (unsigned j = 0; j < 16; ++j) { const unsigned c = xb_ld(&bar[XB_XCNT(j)]); sum += c; cnt += (c > 0u) ? 1u : 0u; mine = (j == x) ? c : mine; }
        if (sum == G) break;
        __builtin_amdgcn_s_sleep(1);
        if ((++sp & 255u) == 0u) { if (xb_ld(&bar[XB_TMO])) break; if (sp > XB_SPIN_CAP) { atomicAdd(&bar[XB_TMO], 1u); break; } }
    }
    nloc = mine > 0u ? mine : 1u; nx = cnt > 0u ? cnt : 1u;
}

__device__ __forceinline__ void xcd_barrier(const XcdBarrier& b) {
    asm volatile("s_waitcnt vmcnt(0)" ::: "memory");
    __syncthreads();
    if (threadIdx.x == 0) {
        unsigned* bar = b.bar;
        __builtin_amdgcn_s_waitcnt(0);
        unsigned nloc = b.st[0], nx = b.st[1];
        if (nloc == 0u) { xcd_barrier_complete(bar, b.x, nloc, nx); b.st[0] = nloc; b.st[1] = nx; }
        const unsigned old = xb_add(&bar[XB_XSUB(b.x)], 1u);
        const unsigned gen = old / nloc;
        if (old + 1u == (gen + 1u) * nloc) {
            __builtin_amdgcn_fence(__ATOMIC_RELEASE, "agent");
            asm volatile("s_waitcnt vmcnt(0)" ::: "memory");
            const unsigned og = xb_add(&bar[XB_TOP], 1u);
            const unsigned tg = og / nx;
            if (og + 1u == (tg + 1u) * nx) xb_add(&bar[XB_TOPGEN], 1u);
            else XB_SPIN(xb_ld(&bar[XB_TOPGEN]) == tg, bar);
            __builtin_amdgcn_fence(__ATOMIC_ACQUIRE, "agent");
            xb_add(&bar[XB_XGEN(b.x)], 1u);
            asm volatile("s_waitcnt vmcnt(0)" ::: "memory");
        } else {
            XB_SPIN(xb_ld(&bar[XB_XGEN(b.x)]) == gen, bar);
            __builtin_amdgcn_fence(__ATOMIC_ACQUIRE, "agent");
            asm volatile("s_waitcnt vmcnt(0)" ::: "memory");
        }
    }
    __syncthreads();
}
constexpr int NWAVES = 8, NTHR = 512;
constexpr int RING_OFF = 0, RING_BYTES = 131072, LDSCTL_OFF = RING_BYTES, MISC_OFF = LDSCTL_OFF + 320, LDS_BYTES = 147456;
constexpr size_t CTL_ZERO_BYTES = 32768;
constexpr int CW_TMO = 0, CW_BAR = 4096;
enum { F_PROJ = 1, F_ATTN = 2, F_RET = 4, F_MERGE = 8, F_OUT = 16, F_DEC = 32, F_ALL = 63 };
typedef unsigned v4u __attribute__((ext_vector_type(4)));
typedef float f32x4 __attribute__((ext_vector_type(4)));
typedef float f32x16 __attribute__((ext_vector_type(16)));
typedef short bf16x8 __attribute__((ext_vector_type(8)));
typedef short s16x4 __attribute__((ext_vector_type(4)));
#define LDS_WAIT() asm volatile("s_waitcnt lgkmcnt(0)" ::: "memory")
__device__ __forceinline__ unsigned pk2(float lo, float hi) { return (unsigned)f2bf(lo) | ((unsigned)f2bf(hi) << 16); }
__device__ __forceinline__ int crow16(int r, int hi) { return (r & 3) + 8 * (r >> 2) + 4 * hi; }

__device__ __forceinline__ int wt1_phys(int L) {
    const int pn = L >> 8, sec = pn >> 1, q = L & 255; int p = q;
    if (sec <= 1) p = (q & 63) | (((q >> 7) & 1) << 6) | (((q >> 6) & 1) << 7);
    else if (sec == 4 || sec == 5) p = (((q >> 3) & 1) << 7) | (((q >> 6) & 3) << 5) | (((q >> 4) & 3) << 3) | (q & 7);
    return (pn << 8) | p;
}
template <bool PERMUTE> __device__ __forceinline__ void p0_transpose_item(const float* W, int K, int N, u16* WT, LAS float* scr, int item, int lane) {
    const int nblk = N / 32, kb = item / nblk, nb = item % nblk, k0 = 64 * kb, n0 = 32 * nb;
#pragma unroll 8
    for (int i = 0; i < 32; ++i) { const int kk = 2 * i + (lane >> 5); scr[kk * 33 + (lane & 31)] = W[(size_t)(k0 + kk) * N + n0 + (lane & 31)]; }
    LDS_WAIT(); asm volatile("" ::: "memory");
    const int c = lane & 7;
#pragma unroll
    for (int j = 0; j < 4; ++j) { const int n = (lane >> 3) + 8 * j; const LAS float* s = scr + (8 * c) * 33 + n;
        v4u o; o.x = pk2(s[0 * 33], s[1 * 33]); o.y = pk2(s[2 * 33], s[3 * 33]); o.z = pk2(s[4 * 33], s[5 * 33]); o.w = pk2(s[6 * 33], s[7 * 33]);
        const int row = PERMUTE ? wt1_phys(n0 + n) : (n0 + n);
        *(v4u*)(WT + (size_t)row * K + k0 + 8 * c) = o; }
    LDS_WAIT(); asm volatile("" ::: "memory");
}
__device__ __forceinline__ void xn_row(const float* xrow, const float* g, u16* orow, int lane) {
    const f32x4* xr = (const f32x4*)xrow + lane; f32x4 v[4]; float s = 0.f;
#pragma unroll
    for (int j = 0; j < 4; ++j) { v[j] = xr[64 * j]; s += (v[j].x * v[j].x + v[j].y * v[j].y) + (v[j].z * v[j].z + v[j].w * v[j].w); }
    const float rs = rsqrtf(wave_sum(s) * (1.f / DM) + EPS);
    unsigned long long* o8 = (unsigned long long*)orow + lane;
#pragma unroll
    for (int j = 0; j < 4; ++j) { const f32x4 gg = ((const f32x4*)g)[lane + 64 * j];
        o8[64 * j] = (unsigned long long)pk2(v[j].x * rs * gg.x, v[j].y * rs * gg.y) | ((unsigned long long)pk2(v[j].z * rs * gg.z, v[j].w * rs * gg.w) << 32); }
}
template <bool NORM, bool RES, bool USE_WT = false> __device__ __forceinline__ void dec_proj(const float* A, const float* g, const float* W, int N, float* out, const float* R, LAS float* sm, int first_cb, int G, const u16* WT = nullptr) {
    int t = threadIdx.x; asm volatile("" : "+v"(t));
    const int wave = t >> 6, lane = t & 63, ncb = N / 16;
    if (first_cb >= ncb) return;
    for (int r = wave; r < 32; r += 8) { float v[16]; float s = 0.f;
#pragma unroll
        for (int j = 0; j < 16; ++j) { v[j] = A[(size_t)r * 1024 + lane + 64 * j]; s += v[j] * v[j]; }
        const float rs = NORM ? rsqrtf(wave_sum(s) * (1.f / 1024.f) + EPS) : 1.f;
#pragma unroll
        for (int j = 0; j < 16; ++j) sm[r * 1024 + lane + 64 * j] = NORM ? v[j] * rs * g[lane + 64 * j] : v[j]; }
    __syncthreads();
    const int col = t & 15, ks = t >> 4;
    for (int cb = first_cb; cb < ncb; cb += (USE_WT ? ncb : G)) { const int n0 = cb * 16;
        float acc[32];
#pragma unroll
        for (int i = 0; i < 32; ++i) acc[i] = 0.f;
        if constexpr (USE_WT) {
            float wv[32]; const v4u* wp = (const v4u*)(WT + (size_t)(n0 + col) * 1024 + ks * 32);
#pragma unroll
            for (int q = 0; q < 4; ++q) { const v4u w4 = wp[q];
                wv[8 * q] = bf2f((u16)(w4.x & 0xffff)); wv[8 * q + 1] = bf2f((u16)(w4.x >> 16)); wv[8 * q + 2] = bf2f((u16)(w4.y & 0xffff)); wv[8 * q + 3] = bf2f((u16)(w4.y >> 16));
                wv[8 * q + 4] = bf2f((u16)(w4.z & 0xffff)); wv[8 * q + 5] = bf2f((u16)(w4.z >> 16)); wv[8 * q + 6] = bf2f((u16)(w4.w & 0xffff)); wv[8 * q + 7] = bf2f((u16)(w4.w >> 16)); }
#pragma unroll
            for (int kk = 0; kk < 32; ++kk) { const int k = ks * 32 + kk;
#pragma unroll
                for (int i = 0; i < 32; ++i) acc[i] += sm[i * 1024 + k] * wv[kk]; }
        } else {
            for (int kk = 0; kk < 32; ++kk) { const int k = ks * 32 + kk; const float w = W[(size_t)k * N + n0 + col];
#pragma unroll
                for (int i = 0; i < 32; ++i) acc[i] += sm[i * 1024 + k] * w; } }
#pragma unroll
        for (int i = 0; i < 32; ++i) { acc[i] += __shfl_xor(acc[i], 16); acc[i] += __shfl_xor(acc[i], 32); }
        __syncthreads();
        LAS float* red = sm;
        if (lane < 16) {
#pragma unroll
            for (int i = 0; i < 32; ++i) red[(wave * 32 + i) * 16 + col] = acc[i]; }
        __syncthreads();
        { const int i = t >> 4, c = t & 15; float s = 0.f;
#pragma unroll
          for (int q = 0; q < 8; ++q) s += red[(q * 32 + i) * 16 + c];
          const size_t o = (size_t)i * N + n0 + c; out[o] = s + (RES ? R[o] : 0.f); }
        __syncthreads();
        if (!USE_WT && cb + G < ncb) {
            for (int r = wave; r < 4; r += 8) { float v[16]; float s = 0.f;
#pragma unroll
                for (int j = 0; j < 16; ++j) { v[j] = A[(size_t)r * 1024 + lane + 64 * j]; s += v[j] * v[j]; }
                const float rs = NORM ? rsqrtf(wave_sum(s) * (1.f / 1024.f) + EPS) : 1.f;
#pragma unroll
                for (int j = 0; j < 16; ++j) sm[r * 1024 + lane + 64 * j] = NORM ? v[j] * rs * g[lane + 64 * j] : v[j]; }
            __syncthreads(); }
    }
}
__device__ __forceinline__ void dec_proj_in(const float* xs, const float* g, const float* W, float* ZS4, LAS float* sm, int bx, const float* x, u16* XN, int gw, int NGW) {
    int t = threadIdx.x; asm volatile("" : "+v"(t));
    const int wave = t >> 6, lane = t & 63, n0 = 64 * (bx >> 2), kq = bx & 3, k0 = 256 * kq;
    float wv[32];
#pragma unroll
    for (int kk = 0; kk < 32; ++kk) wv[kk] = W[(size_t)(k0 + 32 * wave + kk) * NZ + n0 + lane];
    { f32x4 v[4][4];
#pragma unroll
      for (int q = 0; q < 4; ++q)
#pragma unroll
          for (int j = 0; j < 4; ++j) v[q][j] = ((const f32x4*)(xs + (size_t)(wave + 8 * q) * 1024))[lane + 64 * j];
      for (int m = gw; m < M; m += NGW) xn_row(x + (size_t)m * DM, g, XN + (size_t)m * DM, lane);
      f32x4 gg[4];
#pragma unroll
      for (int j = 0; j < 4; ++j) gg[j] = ((const f32x4*)g)[lane + 64 * j];
#pragma unroll
      for (int q = 0; q < 4; ++q) { float s = 0.f;
#pragma unroll
          for (int j = 0; j < 4; ++j) s += (v[q][j].x * v[q][j].x + v[q][j].y * v[q][j].y) + (v[q][j].z * v[q][j].z + v[q][j].w * v[q][j].w);
          const float rs = rsqrtf(wave_sum(s) * (1.f / 1024.f) + EPS);
          f32x4 o = kq == 0 ? v[q][0] * gg[0] : kq == 1 ? v[q][1] * gg[1] : kq == 2 ? v[q][2] * gg[2] : v[q][3] * gg[3];
          ((LAS f32x4*)(sm + (wave + 8 * q) * 256))[lane] = o * rs; } }
    __syncthreads();
    float acc[32];
#pragma unroll
    for (int i = 0; i < 32; ++i) acc[i] = 0.f;
#pragma unroll
    for (int k4 = 0; k4 < 8; ++k4)
#pragma unroll
        for (int i = 0; i < 32; ++i) { const f32x4 a = *(const LAS f32x4*)(sm + i * 256 + 32 * wave + 4 * k4);
            acc[i] += a.x * wv[4 * k4] + a.y * wv[4 * k4 + 1] + a.z * wv[4 * k4 + 2] + a.w * wv[4 * k4 + 3]; }
    LAS float* red = sm + 8192;
#pragma unroll
    for (int i = 0; i < 32; ++i) red[(wave * 32 + i) * 64 + lane] = acc[i];
    __syncthreads();
#pragma unroll
    for (int q = 0; q < 4; ++q) { const int idx = t + 512 * q, i = idx >> 6, c = idx & 63; float s = 0.f;
#pragma unroll
        for (int w = 0; w < 8; ++w) s += red[(w * 32 + i) * 64 + c];
        ZS4[(size_t)(kq * 32 + i) * NZ + n0 + c] = s; }
    __syncthreads();
}
__device__ __forceinline__ void dec_epi(int b, const float* ZS, const float* gq, const float* gk, float* dec, float* outK, float* outV) {
    const int t = threadIdx.x; const float* z0 = ZS + (size_t)b * 4096; const float pos = (float)PAST;
#define z(i_) (z0[(i_)] + z0[(i_) + 32 * 4096] + z0[(i_) + 2 * 32 * 4096] + z0[(i_) + 3 * 32 * 4096])
    { const int h = t >> 7, d = t & 127, i = d & 63; const float fr = exp2f(-(float)i * (13.287712379549449f / 64.f));
      float s, c; sincos_rev(pos * fr, s, c);
      const float q1 = z(h * 128 + i), q2 = z(h * 128 + 64 + i), k1 = z(512 + h * 128 + i), k2 = z(512 + h * 128 + 64 + i);
      dec[D_RQS + b * 512 + t] = d < 64 ? q1 * c - q2 * s : q2 * c + q1 * s;
      dec[D_RKS + b * 512 + t] = (d < 64 ? k1 * c - k2 * s : k2 * c + k1 * s) * 0.08838834764831845f;
      dec[D_RVS + b * 512 + t] = z(1024 + t);
      dec[D_GS + b * 1024 + t] = silu(z(1536 + t)); dec[D_GS + b * 1024 + 512 + t] = silu(z(3584 + t)); }
    { const int d = t & 63; const float fr = exp2f(-(float)(d & 7) * (18.931568569324174f / 8.f));
      float s, c; sincos_rev(pos * fr, s, c);
      const float zq = z(2048 + t), zk = z(2560 + t);
      const float yq = zq * rsqrtf(wave_sum(zq * zq) * (1.f / 64.f) + EPS) * gq[d], yk = zk * rsqrtf(wave_sum(zk * zk) * (1.f / 64.f) + EPS) * gk[d];
      const float pq = __shfl_xor(yq, 8), pk = __shfl_xor(yk, 8);
      const float oq = d < 8 ? yq * c - pq * s : (d < 16 ? yq * c + pq * s : yq);
      const float ok = d < 8 ? yk * c - pk * s : (d < 16 ? yk * c + pk * s : yk);
      dec[D_QS + b * 512 + t] = oq * C2; outK[b * 512 + t] = ok; outV[b * 512 + t] = z(3072 + t); }
}
#undef z
__device__ __forceinline__ void dec_ret(int bh, const float* S, const float* dec, const float* g_ret, float* Sout, float* US, LAS float* sm) {
    const int b = bh >> 2, h = bh & 3, t = threadIdx.x, e = t & 127, dq = t >> 7; const float gam = 1.0f - exp2f(-5.0f - (float)h);
    LAS float* qs = sm; LAS float* ks = sm + 128; LAS float* part = sm + 256; LAS float* red = sm + 768;
    const float* Sp = S + (size_t)bh * 16384; float* So = Sout + (size_t)bh * 16384;
    float sv[32];
#pragma unroll
    for (int dd = 0; dd < 32; ++dd) sv[dd] = Sp[(dq * 32 + dd) * 128 + e];
    const float qv = dec[D_RQS + b * 512 + h * 128 + e], kv = dec[D_RKS + b * 512 + h * 128 + e], v = dec[D_RVS + b * 512 + h * 128 + e];
    const float gt = dec[D_GS + b * 1024 + h * 128 + e], gr = g_ret[e];
    if (t < 128) { qs[t] = qv; ks[t] = kv; }
    const float wqk = wave_sum(qv * kv); if (t < 128 && (t & 63) == 0) red[2 + (t >> 6)] = wqk;
    __syncthreads();
    float qS = 0.f;
#pragma unroll
    for (int dd = 0; dd < 32; ++dd) { const int d = dq * 32 + dd; qS += qs[d] * sv[dd]; So[d * 128 + e] = gam * sv[dd] + ks[d] * v; }
    part[dq * 128 + e] = qS;
    __syncthreads();
    float o = 0.f;
    if (t < 128) { const float qk = red[2] + red[3];
        o = qk * v + gam * (part[e] + part[128 + e] + part[256 + e] + part[384 + e]);
        const float ws = wave_sum(o * o); if ((t & 63) == 0) red[t >> 6] = ws; }
    __syncthreads();
    if (t < 128) { const float rs = rsqrtf((red[0] + red[1]) * (1.f / 128.f) + EPS); US[b * 1024 + h * 128 + e] = o * rs * gr * gt; }
    __syncthreads();
}
template <int CTRL> __device__ __forceinline__ float dppf(float v) { return __builtin_bit_cast(float, __builtin_amdgcn_update_dpp(0, __builtin_bit_cast(int, v), CTRL, 0xf, 0xf, true)); }
#define DPP_X1 0xB1
#define DPP_X2 0x4E
#define DPP_HM 0x141
#define DPP_R8 0x128
__device__ __forceinline__ void dec_comb(int bh, const float* part, const float* dec, const float* newK, const float* newV, const float* g_diff, float lam, float* US, LAS float* sm) {
    const int b = bh >> 2, h = bh & 3, t = threadIdx.x, e = t & 127;
    LAS float* snew = sm; LAS float* onb = sm + 8; LAS float* red = sm + 8 + 256;
    if (t < 128) { const int c = t >> 6, d = t & 63; const float s = wave_sum(dec[D_QS + b * 512 + (2 * h + c) * 64 + d] * newK[b * 512 + (2 * h + c) * 64 + d]); if (d == 0) snew[c] = s; }
    __syncthreads();
    if (t < 256) { const int c = t >> 7, hc = 2 * h + c; const float vn = newV[b * 512 + h * 128 + e]; float mx = snew[c];
        for (int s = 0; s < NSPLIT; ++s) mx = fmaxf(mx, part[((size_t)(b * NSPLIT + s) * 8 + hc) * PSTR]);
        float L = exp2f(snew[c] - mx), O = L * vn;
        for (int s = 0; s < NSPLIT; ++s) { const float* pp = part + ((size_t)(b * NSPLIT + s) * 8 + hc) * PSTR; const float f = exp2f(pp[0] - mx); L += pp[1] * f; O += pp[2 + e] * f; }
        onb[c * 128 + e] = O / L; }
    __syncthreads();
    float o = 0.f;
    if (t < 128) { o = onb[e] - lam * onb[128 + e]; const float ws = wave_sum(o * o); if ((t & 63) == 0) red[t >> 6] = ws; }
    __syncthreads();
    if (t < 128) { const float rs = rsqrtf((red[0] + red[1]) * (1.f / 128.f) + EPS); US[b * 1024 + 512 + h * 128 + e] = o * rs * g_diff[e] * (1.f - LAM_INIT) * dec[D_GS + b * 1024 + 512 + h * 128 + e]; }
    __syncthreads();
}
#define MFMA32(a, b, c) __builtin_amdgcn_mfma_f32_32x32x16_bf16((a), (b), (c), 0, 0, 0)
template <int OFF> __device__ __forceinline__ void rt_glds(const void* sbase, unsigned voff, unsigned lds_dst) { unsigned keep;
    asm volatile("s_mov_b32 %0, m0\n\ts_mov_b32 m0, %3\n\ts_nop 0\n\tglobal_load_lds_dwordx4 %1, %2 offset:%c4\n\ts_mov_b32 m0, %0" : "=&s"(keep) : "v"(voff), "s"(sbase), "s"(lds_dst - (unsigned)OFF), "i"(OFF) : "memory"); }
__device__ __forceinline__ void rt_stage(const void* sbase, unsigned pitch, unsigned lds_dst, int wave, int lane) {
#pragma unroll
    for (int k = 0; k < 4; ++k) { const int p = wave + 8 * k; const unsigned row = 4 * p + (lane >> 4), ch = (lane & 15) ^ (((lane >> 4) << 2) | (p & 3));
        rt_glds<0>(sbase, row * pitch + ch * 16, (unsigned)__builtin_amdgcn_readfirstlane(lds_dst + p * 1024)); }
}
__device__ __forceinline__ int rt_swz(int row, int ch) { return row * 256 + ((ch ^ (((row & 3) << 2) | ((row >> 2) & 3))) << 4); }
typedef const __attribute__((address_space(3))) bf16x8* rt_p16; typedef unsigned u32x2 __attribute__((ext_vector_type(2))); typedef const __attribute__((address_space(3))) u32x2* rt_p8;
__device__ __forceinline__ void ret_r1x2(const u16* VT, const u16* KTD, float* RA, int t0, int t1, LAS unsigned char* L, int wave, int lane) {
    const unsigned l0 = (unsigned)(uintptr_t)L;
    if (t0 >= 0) { rt_stage(VT + (size_t)t0 * 16384, 256, l0, wave, lane); rt_stage(KTD + (size_t)t0 * 16384, 256, l0 + 32768, wave, lane); }
    if (t1 >= 0) { rt_stage(VT + (size_t)t1 * 16384, 256, l0 + 65536, wave, lane); rt_stage(KTD + (size_t)t1 * 16384, 256, l0 + 98304, wave, lane); }
    asm volatile("s_waitcnt vmcnt(0)" ::: "memory"); __syncthreads();
    const int r = lane & 31, hi = lane >> 5, eb = wave & 3, dbp = wave >> 2;
#pragma unroll
    for (int u = 0; u < 2; ++u) { const int ti = u ? t1 : t0; if (ti < 0) continue;
        const LAS unsigned char* Lv = L + u * 65536; const LAS unsigned char* Lk = Lv + 32768;
        f32x16 a0 = {}, a1 = {};
#pragma unroll
        for (int s = 0; s < 8; ++s) { const bf16x8 a = *(rt_p16)(Lv + rt_swz(eb * 32 + r, 2 * s + hi)), b0 = *(rt_p16)(Lk + rt_swz(dbp * 64 + r, 2 * s + hi)), b1 = *(rt_p16)(Lk + rt_swz(dbp * 64 + 32 + r, 2 * s + hi));
            a0 = MFMA32(a, b0, a0); a1 = MFMA32(a, b1, a1); }
        float* o = RA + (size_t)ti * 16384;
#pragma unroll
        for (int q = 0; q < 16; ++q) { const int e = eb * 32 + crow16(q, hi); o[e * 128 + dbp * 64 + r] = a0[q]; o[e * 128 + dbp * 64 + 32 + r] = a1[q]; } }
    __syncthreads();
}
__device__ __forceinline__ void ret_r3(const u16* RQ, const u16* RK, const u16* VT, const u16* ST, const u16* GATE, const float* g_ret, u16* U, int ti, LAS unsigned char* L, int wave, int lane) {
    const int bh = ti >> 5, c = ti & 31, b = bh >> 2, h = bh & 3, r = lane & 31, hi = lane >> 5, tb = wave & 3, eh = wave >> 2;
    const float lg = log2_gamma(h); const size_t row0 = (size_t)b * SEQ + c * 128; const unsigned l0 = (unsigned)(uintptr_t)L;
    rt_stage(RQ + row0 * 512 + h * 128, 1024, l0, wave, lane); rt_stage(RK + row0 * 512 + h * 128, 1024, l0 + 32768, wave, lane);
    rt_stage(VT + (size_t)ti * 16384, 256, l0 + 65536, wave, lane); rt_stage(ST + (size_t)ti * 16384, 256, l0 + 98304, wave, lane);
    asm volatile("s_waitcnt vmcnt(0)" ::: "memory"); __syncthreads();
    const LAS unsigned char* Lq = L; const LAS unsigned char* Lk = L + 32768; const LAS unsigned char* Lv = L + 65536; const LAS unsigned char* Ls = L + 98304;
    LAS float* red = (LAS float*)(L + 131072 + 8192);
    bf16x8 qf[8];
#pragma unroll
    for (int s = 0; s < 8; ++s) qf[s] = *(rt_p16)(Lq + rt_swz(tb * 32 + r, 2 * s + hi));
    f32x16 o0 = {}, o1 = {};
    for (int jb = 0; jb <= tb; ++jb) {
        f32x16 sT = {};
#pragma unroll
        for (int s = 0; s < 8; ++s) sT = MFMA32(*(rt_p16)(Lk + rt_swz(jb * 32 + r, 2 * s + hi)), qf[s], sT);
        float pw[16];
#pragma unroll
        for (int q = 0; q < 16; ++q) { const int dj = (32 * tb + r) - (32 * jb + crow16(q, hi)); pw[q] = dj >= 0 ? sT[q] * exp2f((float)dj * lg) : 0.f; }
        v4u p0, p1; p0.x = pk2(pw[0], pw[1]); p0.y = pk2(pw[2], pw[3]); p0.z = pk2(pw[4], pw[5]); p0.w = pk2(pw[6], pw[7]);
        p1.x = pk2(pw[8], pw[9]); p1.y = pk2(pw[10], pw[11]); p1.z = pk2(pw[12], pw[13]); p1.w = pk2(pw[14], pw[15]);
        const bf16x8 pb0 = __builtin_bit_cast(bf16x8, p0), pb1 = __builtin_bit_cast(bf16x8, p1);
#pragma unroll
        for (int eb = 0; eb < 2; ++eb) { const int e = eh * 64 + eb * 32 + r;
            const u32x2 l0_ = *(rt_p8)(Lv + rt_swz(e, 4 * jb) + 8 * hi), h0_ = *(rt_p8)(Lv + rt_swz(e, 4 * jb + 1) + 8 * hi), l1_ = *(rt_p8)(Lv + rt_swz(e, 4 * jb + 2) + 8 * hi), h1_ = *(rt_p8)(Lv + rt_swz(e, 4 * jb + 3) + 8 * hi);
            const bf16x8 a0 = __builtin_bit_cast(bf16x8, (v4u){l0_.x, l0_.y, h0_.x, h0_.y}), a1 = __builtin_bit_cast(bf16x8, (v4u){l1_.x, l1_.y, h1_.x, h1_.y});
            if (eb == 0) { o0 = MFMA32(a0, pb0, o0); o0 = MFMA32(a1, pb1, o0); } else { o1 = MFMA32(a0, pb0, o1); o1 = MFMA32(a1, pb1, o1); } }
    }
    { f32x16 x0 = {}, x1 = {};
#pragma unroll
      for (int s = 0; s < 8; ++s) { x0 = MFMA32(*(rt_p16)(Ls + rt_swz(eh * 64 + r, 2 * s + hi)), qf[s], x0); x1 = MFMA32(*(rt_p16)(Ls + rt_swz(eh * 64 + 32 + r, 2 * s + hi)), qf[s], x1); }
      const float qd = exp2f((float)(32 * tb + r + 1) * lg);
#pragma unroll
      for (int q = 0; q < 16; ++q) { o0[q] += qd * x0[q]; o1[q] += qd * x1[q]; } }
    float ss = 0.f;
#pragma unroll
    for (int q = 0; q < 16; ++q) ss += o0[q] * o0[q] + o1[q] * o1[q];
    ss += __shfl_xor(ss, 32);
    if (hi == 0) red[wave * 32 + r] = ss;
    __syncthreads();
    const float rs = rsqrtf((red[wave * 32 + r] + red[(wave ^ 4) * 32 + r]) * (1.f / 128.f) + EPS);
    const size_t row = row0 + tb * 32 + r;
#pragma unroll
    for (int eb = 0; eb < 2; ++eb)
#pragma unroll
        for (int g4 = 0; g4 < 4; ++g4) { const int e = eh * 64 + eb * 32 + 8 * g4 + 4 * hi; const size_t o = row * 1024 + h * 128 + e;
            const uint2 gt = *(const uint2*)(GATE + o); const f32x4 gr = *(const f32x4*)(g_ret + e);
            const float y0 = (eb ? o1[4 * g4] : o0[4 * g4]) * rs * gr[0] * bf2f((u16)(gt.x & 0xffff)), y1 = (eb ? o1[4 * g4 + 1] : o0[4 * g4 + 1]) * rs * gr[1] * bf2f((u16)(gt.x >> 16));
            const float y2 = (eb ? o1[4 * g4 + 2] : o0[4 * g4 + 2]) * rs * gr[2] * bf2f((u16)(gt.y & 0xffff)), y3 = (eb ? o1[4 * g4 + 3] : o0[4 * g4 + 3]) * rs * gr[3] * bf2f((u16)(gt.y >> 16));
            uint2 w; w.x = pk2(y0, y1); w.y = pk2(y2, y3); *(uint2*)(U + o) = w; }
    __syncthreads();
}
namespace p2f {
typedef __attribute__((address_space(3))) const char* lcp;
constexpr int KBUF = 8192, K1OFF = 16384, VOFF = 32768, VBUF = 16384, L_DEC = 65536;
template <int OFF> __device__ __forceinline__ void glds16(const void* sbase, unsigned voff, unsigned lds_dst) { unsigned keep;
    asm volatile("s_mov_b32 %0, m0\n\ts_mov_b32 m0, %3\n\ts_nop 0\n\tglobal_load_lds_dwordx4 %1, %2 offset:%c4\n\ts_mov_b32 m0, %0" : "=&s"(keep) : "v"(voff), "s"(sbase), "s"(lds_dst - (unsigned)OFF), "i"(OFF) : "memory"); }
template <int OFF> __device__ __forceinline__ void glds16_nt(const void* sbase, unsigned voff, unsigned lds_dst) { unsigned keep;
    asm volatile("s_mov_b32 %0, m0\n\ts_mov_b32 m0, %3\n\ts_nop 0\n\tglobal_load_lds_dwordx4 %1, %2 offset:%c4 sc1 nt\n\ts_mov_b32 m0, %0" : "=&s"(keep) : "v"(voff), "s"(sbase), "s"(lds_dst - (unsigned)OFF), "i"(OFF) : "memory"); }
__device__ __forceinline__ s16x4 vtr(lcp p) { typedef short v4i16_t __attribute__((ext_vector_type(4))); return __builtin_bit_cast(s16x4, __builtin_amdgcn_ds_read_tr16_b64_v4i16((__attribute__((address_space(3))) v4i16_t*)p)); }
#define P2_WAIT_BAR(n) do { if ((n) == 10) asm volatile("s_waitcnt vmcnt(10) lgkmcnt(0)\n\ts_barrier" ::: "memory"); else if ((n) == 8) asm volatile("s_waitcnt vmcnt(8) lgkmcnt(0)\n\ts_barrier" ::: "memory"); \
        else if ((n) == 2) asm volatile("s_waitcnt vmcnt(2) lgkmcnt(0)\n\ts_barrier" ::: "memory"); else asm volatile("s_waitcnt vmcnt(0) lgkmcnt(0)\n\ts_barrier" ::: "memory"); } while (0)

typedef float f32x2_t __attribute__((ext_vector_type(2))); typedef __bf16 bf16x2_t __attribute__((ext_vector_type(2)));
__device__ __forceinline__ unsigned cvtpk(float lo, float hi) { const f32x2_t v = {lo, hi}; return __builtin_bit_cast(unsigned, __builtin_convertvector(v, bf16x2_t)); }
template <bool MASK> __device__ __forceinline__ void h1(lcp kbase, const bf16x8 (&qf)[4], float& lsum, float shift, int qrel  , int hi, bf16x8& pb0, bf16x8& pb1, bf16x8& pb2, bf16x8& pb3) {
    typedef const __attribute__((address_space(3))) bf16x8* kp_t;
    bf16x8 kf[8];
#pragma unroll
    for (int d0 = 0; d0 < 4; ++d0) { kf[2 * d0] = *(kp_t)(kbase + d0 * 2048); kf[2 * d0 + 1] = *(kp_t)(kbase + d0 * 2048 + 512); }
    f32x16 S0 = MFMA32(kf[0], qf[0], (f32x16{})), S1 = MFMA32(kf[1], qf[0], (f32x16{}));
#pragma unroll
    for (int d0 = 1; d0 < 4; ++d0) { S0 = MFMA32(kf[2 * d0], qf[d0], S0); S1 = MFMA32(kf[2 * d0 + 1], qf[d0], S1); }
    float ls = 0.f;
#pragma unroll
    for (int r = 0; r < 16; ++r) { S0[r] = __builtin_amdgcn_exp2f(S0[r] - shift); S1[r] = __builtin_amdgcn_exp2f(S1[r] - shift);
        if (MASK) { const int kv = crow16(r, hi); if (kv > qrel) S0[r] = 0.f; if (kv + 32 > qrel) S1[r] = 0.f; }
        ls += S0[r] + S1[r]; }
    lsum += ls;
    v4u w0, w1, w2, w3;
    w0.x = cvtpk(S0[0], S0[1]); w0.y = cvtpk(S0[2], S0[3]); w0.z = cvtpk(S0[4], S0[5]); w0.w = cvtpk(S0[6], S0[7]);
    w1.x = cvtpk(S0[8], S0[9]); w1.y = cvtpk(S0[10], S0[11]); w1.z = cvtpk(S0[12], S0[13]); w1.w = cvtpk(S0[14], S0[15]);
    w2.x = cvtpk(S1[0], S1[1]); w2.y = cvtpk(S1[2], S1[3]); w2.z = cvtpk(S1[4], S1[5]); w2.w = cvtpk(S1[6], S1[7]);
    w3.x = cvtpk(S1[8], S1[9]); w3.y = cvtpk(S1[10], S1[11]); w3.z = cvtpk(S1[12], S1[13]); w3.w = cvtpk(S1[14], S1[15]);
    pb0 = __builtin_bit_cast(bf16x8, w0); pb1 = __builtin_bit_cast(bf16x8, w1); pb2 = __builtin_bit_cast(bf16x8, w2); pb3 = __builtin_bit_cast(bf16x8, w3);
}
#define P2_VLOAD(dst, g) do { _Pragma("unroll") for (int k_ = 0; k_ < 2; ++k_) { dst[2 * k_] = vtr(vbase + ((g) >> 1) * 4096 + (((g) & 1) * 2 + k_) * 1024); dst[2 * k_ + 1] = vtr(vbase + ((g) >> 1) * 4096 + (((g) & 1) * 2 + k_) * 1024 + 512); } } while (0)
#define P2_VFR(src, k) (bf16x8){src[2 * (k)][0], src[2 * (k)][1], src[2 * (k)][2], src[2 * (k)][3], src[2 * (k) + 1][0], src[2 * (k) + 1][1], src[2 * (k) + 1][2], src[2 * (k) + 1][3]}
#define P2_PV(src, g) do { if ((g) & 1) { O[(g) >> 1] = MFMA32(P2_VFR(src, 0), pb2, O[(g) >> 1]); O[(g) >> 1] = MFMA32(P2_VFR(src, 1), pb3, O[(g) >> 1]); } \
                           else { O[(g) >> 1] = MFMA32(P2_VFR(src, 0), pb0, O[(g) >> 1]); O[(g) >> 1] = MFMA32(P2_VFR(src, 1), pb1, O[(g) >> 1]); } } while (0)
__device__ __forceinline__ void h2(lcp vbase, f32x16 (&O)[4], const bf16x8& pb0, const bf16x8& pb1, const bf16x8& pb2, const bf16x8& pb3) {
    s16x4 va[4], vb[4];
    P2_VLOAD(va, 0); __builtin_amdgcn_sched_barrier(0);
    P2_VLOAD(vb, 1); __builtin_amdgcn_sched_barrier(0); P2_PV(va, 0); __builtin_amdgcn_sched_barrier(0);
    P2_VLOAD(va, 2); __builtin_amdgcn_sched_barrier(0); P2_PV(vb, 1); __builtin_amdgcn_sched_barrier(0);
    P2_VLOAD(vb, 3); __builtin_amdgcn_sched_barrier(0); P2_PV(va, 2); __builtin_amdgcn_sched_barrier(0);
    P2_VLOAD(va, 4); __builtin_amdgcn_sched_barrier(0); P2_PV(vb, 3); __builtin_amdgcn_sched_barrier(0);
    P2_VLOAD(vb, 5); __builtin_amdgcn_sched_barrier(0); P2_PV(va, 4); __builtin_amdgcn_sched_barrier(0);
    P2_VLOAD(va, 6); __builtin_amdgcn_sched_barrier(0); P2_PV(vb, 5); __builtin_amdgcn_sched_barrier(0);
    P2_VLOAD(vb, 7); __builtin_amdgcn_sched_barrier(0); P2_PV(va, 6); __builtin_amdgcn_sched_barrier(0);
    P2_PV(vb, 7);
}

#define P2_DEC_ISSUE(n, j) do { const int n_ = (n); if ((n_ & 15) == 0) pgbase = (size_t)__builtin_amdgcn_readfirstlane(pgl[n_ >> 4]) * (PAGE * 512); \
        const size_t o_ = pgbase + (size_t)(wid + 8 * (n_ & 15)) * 512; const float* ck_ = CK + o_; const float* cv_ = CV + o_; \
        const unsigned d_ = (unsigned)__builtin_amdgcn_readfirstlane(dbuf + (j) * 4096); \
        glds16_nt<0>(ck_, dlane, d_); glds16_nt<1024>(ck_, dlane, d_ + 1024); glds16_nt<0>(cv_, dlane, d_ + 2048); glds16_nt<1024>(cv_, dlane, d_ + 3072); } while (0)
#define P2_DEC_READ(j, KA, KB, VA, VB) do { const __attribute__((address_space(3))) f32x4* p_ = (const __attribute__((address_space(3))) f32x4*)(dlds + (j) * 4096 + lane * 32); \
        KA = p_[0]; KB = p_[1]; VA = p_[128]; VB = p_[129]; } while (0)
#define P2_DEC_COMP(KA0, KB0, VA0, VB0, KA1, KB1, VA1, VB1) do { const f32x4 qa = qlds[0], qb = qlds[1]; \
        float s0_ = qa.x * KA0.x + qa.y * KA0.y + qa.z * KA0.z + qa.w * KA0.w + qb.x * KB0.x + qb.y * KB0.y + qb.z * KB0.z + qb.w * KB0.w; \
        float s1_ = qa.x * KA1.x + qa.y * KA1.y + qa.z * KA1.z + qa.w * KA1.w + qb.x * KB1.x + qb.y * KB1.y + qb.z * KB1.z + qb.w * KB1.w; \
        s0_ += dppf<DPP_X1>(s0_); s1_ += dppf<DPP_X1>(s1_); s0_ += dppf<DPP_X2>(s0_); s1_ += dppf<DPP_X2>(s1_); s0_ += dppf<DPP_HM>(s0_); s1_ += dppf<DPP_HM>(s1_); \
        const float mn_ = fmaxf(dm, fmaxf(s0_, s1_)), f_ = __builtin_amdgcn_exp2f(dm - mn_), fo_ = dppf<DPP_R8>(f_); dm = mn_; \
        const float pa_ = __builtin_amdgcn_exp2f(s0_ - mn_), pb_ = __builtin_amdgcn_exp2f(s1_ - mn_), qa_ = dppf<DPP_R8>(pa_), qb_ = dppf<DPP_R8>(pb_); dl = dl * f_ + pa_ + pb_; \
        oa[0] = oa[0] * f_ + pa_ * VA0.x + pb_ * VA1.x; oa[1] = oa[1] * f_ + pa_ * VA0.y + pb_ * VA1.y; oa[2] = oa[2] * f_ + pa_ * VA0.z + pb_ * VA1.z; oa[3] = oa[3] * f_ + pa_ * VA0.w + pb_ * VA1.w; \
        oa[4] = oa[4] * f_ + pa_ * VB0.x + pb_ * VB1.x; oa[5] = oa[5] * f_ + pa_ * VB0.y + pb_ * VB1.y; oa[6] = oa[6] * f_ + pa_ * VB0.z + pb_ * VB1.z; oa[7] = oa[7] * f_ + pa_ * VB0.w + pb_ * VB1.w; \
        ob[0] = ob[0] * fo_ + qa_ * VA0.x + qb_ * VA1.x; ob[1] = ob[1] * fo_ + qa_ * VA0.y + qb_ * VA1.y; ob[2] = ob[2] * fo_ + qa_ * VA0.z + qb_ * VA1.z; ob[3] = ob[3] * fo_ + qa_ * VA0.w + qb_ * VA1.w; \
        ob[4] = ob[4] * fo_ + qa_ * VB0.x + qb_ * VB1.x; ob[5] = ob[5] * fo_ + qa_ * VB0.y + qb_ * VB1.y; ob[6] = ob[6] * fo_ + qa_ * VB0.z + qb_ * VB1.z; ob[7] = ob[7] * fo_ + qa_ * VB0.w + qb_ * VB1.w; } while (0)

__device__ __forceinline__ void run(const u16* DQ, const u16* DK, const u16* DV, const u16* GATE, const float* g_diff, float lam, float shift, u16* U,
                                    const float* CK, const float* CV, const int* PT, const float* dec, float* part, char* lds, int vcu, int du,
                                    const u16* VT, const u16* KTD, float* RA, LAS unsigned char* Lr, int r1_t0, int r1_t1) {
    int tid = threadIdx.x; asm volatile("" : "+v"(tid));
    const int lane = tid & 63, r32 = lane & 31, hi = lane >> 5; const int wid = __builtin_amdgcn_readfirstlane(tid >> 6), c = wid >> 2, wq = wid & 3;
    const unsigned lds0 = (unsigned)(uintptr_t)lds; const lcp lds3 = (lcp)lds;
    const bool has_dec = du < DB * NSPLIT; const int db = has_dec ? du >> 3 : 0, dsp = du & 7;
    typedef __attribute__((address_space(3))) f32x4* lq_t; const lq_t qlds = (lq_t)(lds3 + 133120 + lane * 32);
    const __attribute__((address_space(3))) int* pgl = (const __attribute__((address_space(3))) int*)(lds3 + 133120 + 2048);
    { const float* qsrc = dec + D_QS + db * 512 + lane * 8; const f32x4 qv0 = *(const f32x4*)qsrc, qv1 = *(const f32x4*)(qsrc + 4);
      const int pgv = (has_dec && lane < 8) ? PT[db * NPAGES + dsp * 8 + lane] : 0;
      ret_r1x2(VT, KTD, RA, r1_t0, r1_t1, Lr, wid, lane);
      qlds[0] = qv0; qlds[1] = qv1; if (lane < 8) ((__attribute__((address_space(3))) int*)(lds3 + 133120 + 2048))[lane] = pgv; }
    asm volatile("s_waitcnt vmcnt(0) lgkmcnt(0)" ::: "memory");
    float dm = -1e30f, dl = 0.f, oa[8], ob[8];
#pragma unroll
    for (int i = 0; i < 8; ++i) { oa[i] = 0.f; ob[i] = 0.f; }
    const unsigned dbuf = lds0 + L_DEC + wid * 8192; const lcp dlds = lds3 + L_DEC + wid * 8192;
    const unsigned dlane = lane * 16; size_t pgbase = 0; int dn = 0;
    if (has_dec) { P2_DEC_ISSUE(0, 0); P2_DEC_ISSUE(1, 1); dn = 2; }
    const int bh = vcu >> 4, b = bh >> 2, h = bh & 3, xx = vcu & 15;
    const lcp kfr = lds3 + (c ? K1OFF : 0) + hi * 1024 + r32 * 16;
    const lcp vfr = lds3 + VOFF + ((lane >> 4) & 1) * 32 + (lane & 3) * 8 + (4 * hi + ((lane & 15) >> 2)) * 64;
    const unsigned klane = (unsigned)(lane * 512 + wid * 8) * 2u, vlane = (unsigned)((16 * (wid & 3) + (lane >> 2)) * 512 + (wid >> 2) * 32 + (lane & 3) * 8) * 2u;
    for (int ui = 0; ui < 2; ++ui) {
        const int x = ui == 0 ? 31 - xx : xx, NT = 2 * x + 2; const size_t rowb = (size_t)b * SEQ; const int q0 = 128 * x + 32 * wq;
        const int tstart = (4 * xx) % NT;
#define P2_TAU(t) (((t) + tstart) >= NT ? ((t) + tstart - NT) : ((t) + tstart))
        const u16* kt0 = DK + rowb * 512 + (2 * h) * 64; const u16* vt0 = DV + rowb * 512 + h * 128;
#define P2_K_ISSUE(t) do { const u16* kb__ = kt0 + (size_t)P2_TAU(t) * 64 * 512; const unsigned s_ = (unsigned)__builtin_amdgcn_readfirstlane(lds0 + ((t) & 1) * KBUF + wid * 1024); \
            glds16<0>(kb__, klane, s_); glds16<128>(kb__, klane, s_ + K1OFF); } while (0)
#define P2_V_ISSUE(t) do { const u16* vb__ = vt0 + (size_t)P2_TAU(t) * 64 * 512; const unsigned s_ = (unsigned)__builtin_amdgcn_readfirstlane(lds0 + VOFF + ((t) & 1) * VBUF + wid * 1024); \
            glds16<0>(vb__, vlane, s_); glds16<128>(vb__, vlane, s_ + 8192); } while (0)
        P2_K_ISSUE(0); P2_V_ISSUE(0);
        bf16x8 qf[4]; { const u16* qp = DQ + (rowb + q0 + r32) * 512 + (2 * h + c) * 64 + 8 * hi;
#pragma unroll
            for (int d0 = 0; d0 < 4; ++d0) qf[d0] = *(const bf16x8*)(qp + 16 * d0); }
        asm volatile("" : "+v"(qf[0]), "+v"(qf[1]), "+v"(qf[2]), "+v"(qf[3]));
        f32x16 O[4]; O[0] = f32x16{}; O[1] = f32x16{}; O[2] = f32x16{}; O[3] = f32x16{}; float lsum = 0.f;
        bf16x8 pb0 = {}, pb1 = {}, pb2 = {}, pb3 = {};
        int allow = 0;
        for (int hs = 0; hs <= 2 * NT; ++hs) {
            P2_WAIT_BAR(allow);
            allow = 0;
            if (!(hs & 1)) { const int tn = (hs >> 1) + 1; if (tn < NT) { P2_K_ISSUE(tn); allow = 2; } }
            else { const int tn = (hs + 1) >> 1; if (tn < NT) { P2_V_ISSUE(tn); allow = 2; } }
            if ((hs & 1) == c) {
                const int t = (hs - c) >> 1;
                const int tau = P2_TAU(t);
                if (t < NT && !(tau == NT - 1 && wq < 2)) { const lcp kb_ = kfr + (t & 1) * KBUF; const int qrel = q0 + r32 - 64 * tau;
                    if (tau < NT - 2) h1<false>(kb_, qf, lsum, shift, qrel, hi, pb0, pb1, pb2, pb3); else h1<true>(kb_, qf, lsum, shift, qrel, hi, pb0, pb1, pb2, pb3); }
            } else {
                if (has_dec && (dn - 2) < 128) {
                    f32x4 ka0, kb0, va0, vb0, ka1, kb1, va1, vb1;
                    P2_DEC_READ(0, ka0, kb0, va0, vb0); P2_DEC_READ(1, ka1, kb1, va1, vb1); asm volatile("s_waitcnt lgkmcnt(0)" ::: "memory");
                    if (dn < 128) { P2_DEC_ISSUE(dn, 0); P2_DEC_ISSUE(dn + 1, 1); allow += 8; } dn += 2;
                    P2_DEC_COMP(ka0, kb0, va0, vb0, ka1, kb1, va1, vb1); }
                __builtin_amdgcn_sched_barrier(0);
                const int t = (hs - 1 - c) >> 1;
                if (hs - 1 - c >= 0 && t < NT && !(P2_TAU(t) == NT - 1 && wq < 2)) h2(vfr + (t & 1) * VBUF, O, pb0, pb1, pb2, pb3);
            }
        }
        lsum += __shfl_xor(lsum, 32); const float inv = 1.0f / lsum;
#pragma unroll
        for (int eb = 0; eb < 4; ++eb)
#pragma unroll
            for (int r = 0; r < 16; ++r) O[eb][r] *= inv;
        asm volatile("s_waitcnt lgkmcnt(0)\n\ts_barrier" ::: "memory");
        __attribute__((address_space(3))) f32x4* ex = (__attribute__((address_space(3))) f32x4*)(lds3) + (wq * 16) * 64 + lane;
        if (c == 1) {
#pragma unroll
            for (int eb = 0; eb < 4; ++eb)
#pragma unroll
                for (int g4 = 0; g4 < 4; ++g4) ex[(eb * 4 + g4) * 64] = (f32x4){O[eb][4 * g4], O[eb][4 * g4 + 1], O[eb][4 * g4 + 2], O[eb][4 * g4 + 3]}; }
        asm volatile("s_waitcnt lgkmcnt(0)\n\ts_barrier" ::: "memory");
        if (c == 0) { float ss = 0.f;
#pragma unroll
            for (int eb = 0; eb < 4; ++eb) {
#pragma unroll
                for (int g4 = 0; g4 < 4; ++g4) { const f32x4 o1 = ex[(eb * 4 + g4) * 64];
#pragma unroll
                    for (int i = 0; i < 4; ++i) { const float o = O[eb][4 * g4 + i] - lam * o1[i]; O[eb][4 * g4 + i] = o; ss += o * o; } }
                __builtin_amdgcn_sched_barrier(0); }
            ss += __shfl_xor(ss, 32);
            const float rs = rsqrtf(ss * (1.f / 128.f) + EPS) * (1.f - LAM_INIT); const size_t row = rowb + q0 + r32;
#pragma unroll
            for (int eb = 0; eb < 4; ++eb)
#pragma unroll
                for (int g4 = 0; g4 < 4; ++g4) { const int e = eb * 32 + 8 * g4 + 4 * hi; const size_t o = row * 1024 + 512 + h * 128 + e;
                    const uint2 gt = *(const uint2*)(GATE + o); const f32x4 gr = *(const f32x4*)(g_diff + e);
                    uint2 w; w.x = pk2(O[eb][4 * g4] * rs * gr[0] * bf2f((u16)(gt.x & 0xffff)), O[eb][4 * g4 + 1] * rs * gr[1] * bf2f((u16)(gt.x >> 16)));
                    w.y = pk2(O[eb][4 * g4 + 2] * rs * gr[2] * bf2f((u16)(gt.y & 0xffff)), O[eb][4 * g4 + 3] * rs * gr[3] * bf2f((u16)(gt.y >> 16)));
                    *(uint2*)(U + o) = w; if (g4 == 3) __builtin_amdgcn_sched_barrier(0); } }
        asm volatile("s_waitcnt lgkmcnt(0)\n\ts_barrier" ::: "memory");
#undef P2_K_ISSUE
#undef P2_V_ISSUE
#undef P2_TAU
    }
    if (has_dec) {
        while (dn - 2 < 128) { asm volatile("s_waitcnt vmcnt(0)" ::: "memory"); f32x4 ka0, kb0, va0, vb0, ka1, kb1, va1, vb1;
            P2_DEC_READ(0, ka0, kb0, va0, vb0); P2_DEC_READ(1, ka1, kb1, va1, vb1); asm volatile("s_waitcnt lgkmcnt(0)" ::: "memory");
            if (dn < 128) { P2_DEC_ISSUE(dn, 0); P2_DEC_ISSUE(dn + 1, 1); } dn += 2;
            P2_DEC_COMP(ka0, kb0, va0, vb0, ka1, kb1, va1, vb1); }
        __syncthreads();
        __attribute__((address_space(3))) float* sm = (__attribute__((address_space(3))) float*)lds3;
        { const int hh = lane >> 4, co = (lane >> 3) & 1, e0 = 8 * (lane & 15);
#pragma unroll
          for (int i = 0; i < 8; ++i) { sm[(wid * 8 + hh * 2 + co) * PSTR + 2 + e0 + i] = oa[i]; sm[(wid * 8 + hh * 2 + (co ^ 1)) * PSTR + 2 + e0 + i] = ob[i]; }
          if ((lane & 7) == 0) { sm[(wid * 8 + (lane >> 3)) * PSTR] = dm; sm[(wid * 8 + (lane >> 3)) * PSTR + 1] = dl; } }
        __syncthreads();
        for (int idx = tid; idx < 8 * 128; idx += 512) { const int hc = idx >> 7, e = idx & 127; float mx = -1e30f;
            for (int w = 0; w < 8; ++w) mx = fmaxf(mx, sm[(w * 8 + hc) * PSTR]);
            float Ls = 0.f, Os = 0.f;
            for (int w = 0; w < 8; ++w) { const float f = exp2f(sm[(w * 8 + hc) * PSTR] - mx); Ls += sm[(w * 8 + hc) * PSTR + 1] * f; Os += sm[(w * 8 + hc) * PSTR + 2 + e] * f; }
            float* pp = part + ((size_t)(db * NSPLIT + dsp) * 8 + hc) * PSTR; pp[2 + e] = Os; if (e == 0) { pp[0] = mx; pp[1] = Ls; } }
        __syncthreads();
    }
}
#undef P2_WAIT_BAR
}

struct Args { const void* in[17]; float* out; unsigned char* ws; int ph_lo, ph_hi, mask, pad; };
__global__ void __launch_bounds__(NTHR, 2) mega(Args args) {
    extern __shared__ __attribute__((aligned(16))) unsigned char lds[];
    LAS unsigned char* L = (LAS unsigned char*)lds;
    volatile LAS unsigned* MISC = (volatile LAS unsigned*)(L + MISC_OFF);
    const int tid = threadIdx.x, lane = tid & 63, wave = __builtin_amdgcn_readfirstlane(tid >> 6), G = gridDim.x, bx = blockIdx.x;
    const int vcu = (G % 8 == 0) ? (bx % 8) * (G / 8) + bx / 8 : bx;
    const int mask = args.mask, lo = args.ph_lo, hi = args.ph_hi;
    unsigned char* ws = args.ws; float* out = args.out;
    const float* x = (const float*)args.in[0]; const float* xs = (const float*)args.in[1]; const float* CK = (const float*)args.in[2]; const float* CV = (const float*)args.in[3];
    const float* Sret = (const float*)args.in[4]; const int* PT = (const int*)args.in[5]; const float* ng = (const float*)args.in[6]; const float* w_in = (const float*)args.in[7]; const float* w_out = (const float*)args.in[8];
    const float* gq = (const float*)args.in[9]; const float* gk = (const float*)args.in[10]; const float* g_ret = (const float*)args.in[11]; const float* g_diff = (const float*)args.in[12];
    const float* lq1 = (const float*)args.in[13]; const float* lk1 = (const float*)args.in[14]; const float* lq2 = (const float*)args.in[15]; const float* lk2 = (const float*)args.in[16];
    u16 *WT1 = (u16*)(ws + WS_WT1), *WT2 = (u16*)(ws + WS_WT2), *XN = (u16*)(ws + WS_XN), *RQ = (u16*)(ws + WS_RQ), *RK = (u16*)(ws + WS_RK), *KTD = (u16*)(ws + WS_KTD), *VT = (u16*)(ws + WS_VT),
        *GATE = (u16*)(ws + WS_GATE), *DQ = (u16*)(ws + WS_DQ), *DK = (u16*)(ws + WS_DK), *DV = (u16*)(ws + WS_DV), *AO = (u16*)(ws + WS_AO), *ST = (u16*)(ws + WS_ST), *U = (u16*)(ws + WS_U);
    float* RA = (float*)(ws + WS_RA); float* dec = (float*)(ws + WS_DEC); unsigned* ctl = (unsigned*)(ws + WS_CTL);
    for (int u = tid; u < (LDS_BYTES - LDSCTL_OFF) / 4; u += NTHR) ((LAS unsigned*)(L + LDSCTL_OFF))[u] = 0u;
    __syncthreads();
    XcdBarrier bar = xcd_barrier_post(ctl + CW_BAR, MISC + 8);
#define IN(k) (lo <= (k) && (k) < hi)
#define BOTH(k) (IN(k) && IN((k) + 1))
    const int gw = vcu * NWAVES + wave, NGW = G * NWAVES;

#define DO_P0 do { \
        if (mask & F_DEC) { dec_proj_in(xs, ng, w_in, dec + D_ZS4, (LAS float*)(L + RING_OFF), bx, x, XN, gw, NGW); }     \
        LAS float* scr = (LAS float*)(L + RING_OFF + wave * 16384); \
        constexpr int I1 = (DM / 64) * (NZ / 32), I2 = (DM / 64) * (DM / 32); \
        for (int it = gw; it < I1 + I2; it += NGW) { if (it < I1) p0_transpose_item<true>(w_in, DM, NZ, WT1, scr, it, lane); else p0_transpose_item<false>(w_out, DM, DM, WT2, scr, it - I1, lane); } \
        if (!(mask & F_DEC)) { for (int m = gw; m < M; m += NGW) xn_row(x + (size_t)m * DM, ng, XN + (size_t)m * DM, lane); } } while (0)
    if (IN(0)) {
        DO_P0;
        if (BOTH(0)) xcd_barrier(bar);
    }
    if (IN(1)) {
#define DO_P1 do { pg8::Gemm g{XN, WT1, M, NZ, DM}; pg8::StaticOrder S; S.init(M, NZ, G, bx); \
            pg8::EpiProj E{RQ, RK, KTD, VT, GATE, DQ, DK, DV, out + O_KP, out + O_VP, gq, gk}; \
            pg8::gemm_phase<pg8::EpiProj, pg8::StaticOrder, true, true>(L + RING_OFF, g, S, E); } while (0)
        if (mask & F_PROJ) { DO_P1; }
        if (mask & F_DEC) { for (int b = bx; b < DB; b += G) dec_epi(b, dec + D_ZS4, gq, gk, dec, out + O_KS, out + O_VS); }
        if (BOTH(1)) xcd_barrier(bar);
    }
    if (IN(2)) {
#define DO_P2R do { for (int ti = bx; ti < 512; ti += 2 * G) ret_r1x2(VT, KTD, RA, ti, ti + G < 512 ? ti + G : -1, L + RING_OFF, wave, lane); } while (0)
        { const float mq = wave_max(fabsf(gq[lane])), mk = wave_max(fabsf(gk[lane])); const float bnd = fmaxf(8.f * LOG2E * mq * mk - 60.f, 0.f);
          const float a_ = wave_sum(lq1[lane] * lk1[lane]), c_ = wave_sum(lq2[lane] * lk2[lane]); const float lam2 = __expf(a_) - __expf(c_) + LAM_INIT;
          p2f::run(DQ, DK, DV, GATE, g_diff, lam2, bnd, U, CK, CV, PT, dec, dec + D_PART, (char*)lds + RING_OFF, vcu, vcu, VT, KTD, RA, L + RING_OFF, bx, bx + G < 512 ? bx + G : -1); }
        if (BOTH(2)) xcd_barrier(bar);
    }
    float lam = 0.f;
    if (IN(3) || IN(4)) { const float a = wave_sum(lq1[lane] * lk1[lane]), c = wave_sum(lq2[lane] * lk2[lane]); lam = __expf(a) - __expf(c) + LAM_INIT; }
    if (IN(3)) {
        if (mask & F_RET) {
            for (int idx = bx * NTHR + tid; idx < 16 * 16384; idx += G * NTHR) { const int bh = idx >> 14, ed = idx & 16383; const float g128 = exp2f(128.f * log2_gamma(bh & 3));
                const float* ra = RA + ((size_t)bh * 32 << 14) + ed; u16* st = ST + ((size_t)bh * 32 << 14) + ed; float S = 0.f;
                float av[32];
#pragma unroll
                for (int c = 0; c < 32; ++c) av[c] = ra[(size_t)c << 14];
#pragma unroll
                for (int c = 0; c < 32; ++c) { st[(size_t)c << 14] = f2bf(S); S = g128 * S + av[c]; }
                out[O_RP + (size_t)bh * 16384 + (ed & 127) * 128 + (ed >> 7)] = S; }
        }
        if (mask & F_DEC) { for (int u = (bx + G / 2) % G; u < DB * 4; u += G) dec_ret(u, Sret, dec, g_ret, out + O_RS, dec + D_US, (LAS float*)(L + RING_OFF));
            for (int u = bx; u < DB * 4; u += G) dec_comb(u, dec + D_PART, dec, out + O_KS, out + O_VS, g_diff, lam, dec + D_US, (LAS float*)(L + RING_OFF)); }
        if (BOTH(3)) xcd_barrier(bar);
    }
    if (IN(4)) {
#define DO_P4 do { for (int ti = bx; ti < 512; ti += G) ret_r3(RQ, RK, VT, ST, GATE, g_ret, U, ti, L + RING_OFF, wave, lane); } while (0)
        DO_P4;
        if (mask & F_DEC) { __syncthreads(); dec_proj<false, true, true>(dec + D_US, nullptr, w_out, DM, out + O_YS, xs, (LAS float*)(L + RING_OFF), bx, G, WT2); }
        if (BOTH(4)) xcd_barrier(bar);
    }
    if (IN(5)) {
#define DO_P5 do { pg8::Gemm g{U, WT2, M, DM, DM}; pg8::StaticOrder S; S.init(M, DM, G, bx); pg8::EpiRes E{x, out + O_YP}; \
            pg8::gemm_phase<pg8::EpiRes, pg8::StaticOrder, true, true>(L + RING_OFF, g, S, E); } while (0)
        if (mask & F_OUT) { DO_P5; }

    }
#undef IN
#undef BOTH
}
#ifndef MK_N_LAUNCHES
#define MK_N_LAUNCHES 1
#endif
#ifndef MK_MASK
#define MK_MASK F_ALL
#endif
extern "C" void kernel_launch(void* const* d_in, const int* in_sizes, int n_in, void* d_out, int out_size, void* d_ws, size_t ws_size, hipStream_t stream) {
    static int grid = 0;
    if (grid == 0) {
        if (n_in != 17 || (size_t)out_size != O_END || ws_size < WS_END) { fprintf(stderr, "kernel_launch: unexpected sizes n_in %d out %d ws %zu\n", n_in, out_size, ws_size); grid = -1; return; }
        int dev = 0, cus = 0, per_cu = 0;
        if (hipGetDevice(&dev) != hipSuccess || hipDeviceGetAttribute(&cus, hipDeviceAttributeMultiprocessorCount, dev) != hipSuccess) { grid = -1; return; }
        if (hipFuncSetAttribute((const void*)mega, hipFuncAttributeMaxDynamicSharedMemorySize, LDS_BYTES) != hipSuccess) { fprintf(stderr, "kernel_launch: hipFuncSetAttribute failed\n"); grid = -1; return; }
        if (hipOccupancyMaxActiveBlocksPerMultiprocessor(&per_cu, (const void*)mega, NTHR, LDS_BYTES) != hipSuccess || per_cu < 1) { fprintf(stderr, "kernel_launch: occupancy query says %d\n", per_cu); }
        (void)hipGetLastError();
        grid = cus;
        if (grid != 256) { fprintf(stderr, "kernel_launch: this kernel's phase P2 is dealt for exactly 256 CUs (got %d)\n", grid); grid = -1; return; }
    }
    if (grid < 0) return;
    if (hipMemsetAsync((char*)d_ws + WS_CTL, 0, CTL_ZERO_BYTES, stream) != hipSuccess) return;
    Args a{};
    for (int i = 0; i < 17; ++i) a.in[i] = d_in[i];
    a.out = (float*)d_out; a.ws = (unsigned char*)d_ws; a.mask = MK_MASK; a.pad = 0;
#if MK_N_LAUNCHES == 1
    a.ph_lo = 0; a.ph_hi = 6;
    hipLaunchKernelGGL(mega, dim3(grid), dim3(NTHR), LDS_BYTES, stream, a);
#endif
}
```
